# Optimizing an MI355X kernel written in HIP

```python
import math
import jax, jax.numpy as jnp
from jax import lax
import numpy as np

D_MODEL = 1024
BATCH = 4
SEQ = 4096
DEPTH = 4
DEC_BATCH = 128
DEC_SEQ = 1
PAST_LEN = 8192
PAGE_SIZE = 128

N_META = 16
EPS = 1e-6
D_FF = 2816
N_HEADS = 8
N_KV = 2
HEAD_DIM = 64
Q_PER_KV = N_HEADS // N_KV
WINDOW = 128
BLOCK = 128
ROPE_DIM = HEAD_DIM // 4
ROPE_THETA = 500000.0
SCALE = HEAD_DIM ** -0.5
C_CONV = 512
CONV_W = 31
D_SSM = D_MODEL
SSM_GROUP = 16
N_GROUPS = D_SSM // SSM_GROUP
SSM_STATE = 64
N_EVEN = (DEPTH + 1) // 2
N_ODD = DEPTH // 2
ATT_W = N_HEADS * HEAD_DIM
KV_W = N_KV * HEAD_DIM
IN_AB = ATT_W + 2 * KV_W + 2 * C_CONV
OUT_AB = ATT_W + C_CONV

kernel_name = 'hybrid_conformer_swa_s5_macaron_step'


def rmsnorm(x, g):
    xf = x.astype(jnp.float32)
    y = xf * lax.rsqrt(jnp.mean(xf * xf, axis=-1, keepdims=True) + EPS)
    return (y * g.astype(jnp.float32)).astype(x.dtype)


def layernorm(x, g, b):
    xf = x.astype(jnp.float32)
    mu = jnp.mean(xf, axis=-1, keepdims=True)
    xc = xf - mu
    y = xc * lax.rsqrt(jnp.mean(xc * xc, axis=-1, keepdims=True) + EPS)
    return (y * g.astype(jnp.float32) + b.astype(jnp.float32)).astype(x.dtype)


def swiglu(h, w_gu, w_down):
    gate, up = jnp.split(h @ w_gu, 2, axis=-1)
    return (jax.nn.silu(gate) * up) @ w_down


def rope_partial(x, pos):
    half = ROPE_DIM // 2
    inv = ROPE_THETA ** (-jnp.arange(half, dtype=jnp.float32) * 2.0 / ROPE_DIM)
    ang = pos.astype(jnp.float32)[:, None] * inv[None, :]
    cos = jnp.cos(ang)[:, None, :]
    sin = jnp.sin(ang)[:, None, :]
    xr = x[..., :ROPE_DIM].astype(jnp.float32)
    x1, x2 = xr[..., :half], xr[..., half:]
    rot = jnp.concatenate([x1 * cos - x2 * sin, x2 * cos + x1 * sin], axis=-1).astype(x.dtype)
    return jnp.concatenate([rot, x[..., ROPE_DIM:]], axis=-1)


def sink_probs(scores, mask, sink):
    s = jnp.where(mask, scores, -jnp.inf)
    sk = jnp.broadcast_to(sink.astype(jnp.float32)[:, :, None, None], s.shape[:-1] + (1,))
    p = jax.nn.softmax(jnp.concatenate([s, sk], axis=-1), axis=-1)
    return p[..., :-1]


def ab_project(h, pos, w_in):
    bsz, t, _ = h.shape
    proj = h @ w_in
    o1 = ATT_W
    o2 = o1 + KV_W
    o3 = o2 + KV_W
    o4 = o3 + C_CONV
    q = rope_partial(proj[..., :o1].reshape(bsz, t, N_HEADS, HEAD_DIM), pos)
    k = rope_partial(proj[..., o1:o2].reshape(bsz, t, N_KV, HEAD_DIM), pos)
    v = proj[..., o2:o3].reshape(bsz, t, N_KV, HEAD_DIM)
    z = proj[..., o3:o4] * jax.nn.sigmoid(proj[..., o4:])
    return q, k, v, z


def conv_branch(z, ctx, conv_w, conv_b, ln_g, ln_b):
    zf = jnp.concatenate([ctx.astype(z.dtype), z], axis=1)
    y = lax.conv_general_dilated(zf, conv_w.astype(z.dtype)[:, None, :], (1,), 'VALID',
                                 dimension_numbers=('NWC', 'WIO', 'NWC'),
                                 feature_group_count=C_CONV) + conv_b
    y = jax.nn.silu(layernorm(y, ln_g, ln_b))
    return y, zf[:, -(CONV_W - 1):]


def swa_prompt(q, k, v, sink):
    bsz, L = q.shape[0], q.shape[1]
    pad = (-L) % BLOCK
    lp = L + pad
    nb = lp // BLOCK
    padt = lambda t: jnp.pad(t, ((0, 0), (pad, 0), (0, 0), (0, 0)))
    qb = padt(q).reshape(bsz, nb, BLOCK, N_KV, Q_PER_KV, HEAD_DIM)
    kb = padt(k).reshape(bsz, nb, BLOCK, N_KV, HEAD_DIM)
    vb = padt(v).reshape(bsz, nb, BLOCK, N_KV, HEAD_DIM)
    prev = lambda t: jnp.pad(t[:, :-1], ((0, 0), (1, 0), (0, 0), (0, 0), (0, 0)))
    kk = jnp.concatenate([prev(kb), kb], axis=2)
    vv = jnp.concatenate([prev(vb), vb], axis=2)
    posb = (jnp.arange(lp, dtype=jnp.int32) - pad).reshape(nb, BLOCK)
    kpos = jnp.concatenate([posb - BLOCK, posb], axis=-1)
    diff = posb[:, :, None] - kpos[:, None, :]
    mask = (diff >= 0) & (diff <= WINDOW) & (kpos[:, None, :] >= 0)
    scores = jnp.einsum('bnqkgd,bnskd->bnkgqs', qb.astype(jnp.float32) * SCALE, kk.astype(jnp.float32))
    p = sink_probs(scores, mask[None, :, None, None], sink.reshape(N_KV, Q_PER_KV))
    o = jnp.einsum('bnkgqs,bnskd->bnqkgd', p.astype(vv.dtype), vv)
    o = o.reshape(bsz, lp, ATT_W)[:, pad:]
    keep = min(WINDOW, PAST_LEN)
    return o, k[:, -keep:], v[:, -keep:]


def swa_sample(q, k, v, buf_k, buf_v, sink):
    bsz, t = q.shape[0], q.shape[1]
    keep = buf_k.shape[1]
    kk = jnp.concatenate([buf_k.astype(k.dtype), k], axis=1)
    vv = jnp.concatenate([buf_v.astype(v.dtype), v], axis=1)
    kpos = PAST_LEN - keep + jnp.arange(keep + t, dtype=jnp.int32)
    qpos = PAST_LEN + jnp.arange(t, dtype=jnp.int32)
    diff = qpos[:, None] - kpos[None, :]
    mask = (diff >= 0) & (diff <= WINDOW)
    qg = q.reshape(bsz, t, N_KV, Q_PER_KV, HEAD_DIM)
    scores = jnp.einsum('btkgd,bskd->bkgts', qg.astype(jnp.float32) * SCALE, kk.astype(jnp.float32))
    p = sink_probs(scores, mask[None, None, None], sink.reshape(N_KV, Q_PER_KV))
    o = jnp.einsum('bkgts,bskd->btkgd', p.astype(vv.dtype), vv).reshape(bsz, t, ATT_W)
    return o, kk[:, -keep:], vv[:, -keep:]


def ab_mixer_prompt(h, pos, w_in, w_out, sink, conv_w, conv_b, ln_g, ln_b):
    q, k, v, z = ab_project(h, pos, w_in)
    ctx = jnp.zeros((h.shape[0], CONV_W - 1, C_CONV), z.dtype)
    c_out, c_state = conv_branch(z, ctx, conv_w, conv_b, ln_g, ln_b)
    a_out, k_state, v_state = swa_prompt(q, k, v, sink)
    out = jnp.concatenate([a_out, c_out], axis=-1) @ w_out
    return out, c_state, k_state, v_state


def ab_mixer_sample(h, pos, conv_ctx, buf_k, buf_v, w_in, w_out, sink, conv_w, conv_b, ln_g, ln_b):
    q, k, v, z = ab_project(h, pos, w_in)
    c_out, c_state = conv_branch(z, conv_ctx, conv_w, conv_b, ln_g, ln_b)
    a_out, k_state, v_state = swa_sample(q, k, v, buf_k, buf_v, sink)
    out = jnp.concatenate([a_out, c_out], axis=-1) @ w_out
    return out, c_state, k_state, v_state


def s5_scan(u, s_re, s_im, a_re, a_im, log_dt, b_re, b_im, c_re, c_im, d_skip):
    bsz, t, _ = u.shape
    f32 = jnp.float32
    a_re = a_re.astype(f32)
    a_im = a_im.astype(f32)
    dt = jnp.exp(log_dt.astype(f32))[:, None]
    mag = jnp.exp(a_re * dt)
    ang = a_im * dt
    lam_re = mag * jnp.cos(ang)
    lam_im = mag * jnp.sin(ang)
    den = a_re * a_re + a_im * a_im
    nr = lam_re - 1.0
    f_re = (nr * a_re + lam_im * a_im) / den
    f_im = (lam_im * a_re - nr * a_im) / den
    b_re = b_re.astype(f32)
    b_im = b_im.astype(f32)
    bb_re = f_re[..., None] * b_re - f_im[..., None] * b_im
    bb_im = f_re[..., None] * b_im + f_im[..., None] * b_re
    ug = u.astype(f32).reshape(bsz, t, N_GROUPS, SSM_GROUP)
    x_re = jnp.einsum('btgc,gpc->btgp', ug, bb_re)
    x_im = jnp.einsum('btgc,gpc->btgp', ug, bb_im)
    s_re = s_re.astype(f32)
    s_im = s_im.astype(f32)
    x_re = x_re.at[:, 0].add(lam_re * s_re - lam_im * s_im)
    x_im = x_im.at[:, 0].add(lam_re * s_im + lam_im * s_re)
    la_re = jnp.broadcast_to(lam_re, (1, t) + lam_re.shape)
    la_im = jnp.broadcast_to(lam_im, (1, t) + lam_im.shape)

    def combine(e, l):
        ear, eai, ebr, ebi = e
        lar, lai, lbr, lbi = l
        return (lar * ear - lai * eai, lar * eai + lai * ear,
                lar * ebr - lai * ebi + lbr, lar * ebi + lai * ebr + lbi)

    _, _, h_re, h_im = lax.associative_scan(combine, (la_re, la_im, x_re, x_im), axis=1)
    y = (jnp.einsum('btgp,gcp->btgc', h_re, c_re.astype(f32))
         - jnp.einsum('btgp,gcp->btgc', h_im, c_im.astype(f32)))
    y = y.reshape(bsz, t, D_SSM) + d_skip.astype(f32) * u.astype(f32)
    return y.astype(u.dtype), h_re[:, -1], h_im[:, -1]


def ssm_mixer(h, s_re, s_im, w_in, a_re, a_im, log_dt, b_re, b_im, c_re, c_im, d_skip, w_glu):
    u = h @ w_in
    y, n_re, n_im = s5_scan(u, s_re, s_im, a_re, a_im, log_dt, b_re, b_im, c_re, c_im, d_skip)
    val, gate = jnp.split(jax.nn.gelu(y) @ w_glu, 2, axis=-1)
    return val * jax.nn.sigmoid(gate), n_re, n_im


def setup_inputs(seed: int = 0) -> dict:
    key = jax.random.key(seed)
    ks = iter(jax.random.split(key, 40))
    nrm = lambda shape, s: jax.random.normal(next(ks), shape, jnp.float32) * s
    keep = min(WINDOW, PAST_LEN)
    a_im0 = jnp.broadcast_to(math.pi * jnp.arange(SSM_STATE, dtype=jnp.float32), (N_ODD, N_GROUPS, SSM_STATE))
    return {
        'x_prompt': nrm((BATCH, SEQ, D_MODEL), 1.0),
        'x_sample': nrm((DEC_BATCH, DEC_SEQ, D_MODEL), 1.0),
        'state_conv': nrm((N_EVEN, DEC_BATCH, CONV_W - 1, C_CONV), 0.5),
        'cache_win_k': nrm((N_EVEN, DEC_BATCH, keep, N_KV, HEAD_DIM), 1.0),
        'cache_win_v': nrm((N_EVEN, DEC_BATCH, keep, N_KV, HEAD_DIM), 1.0),
        'state_ssm_re': nrm((N_ODD, DEC_BATCH, N_GROUPS, SSM_STATE), 0.1),
        'state_ssm_im': nrm((N_ODD, DEC_BATCH, N_GROUPS, SSM_STATE), 0.1),
        'meta_tokens': nrm((N_META, D_MODEL), 1.0),
        'norm_g': 1.0 + nrm((DEPTH, 3, D_MODEL), 0.02),
        'final_norm_g': 1.0 + nrm((D_MODEL,), 0.02),
        'ffn1_w_gu': nrm((DEPTH, D_MODEL, 2 * D_FF), D_MODEL ** -0.5),
        'ffn1_w_down': nrm((DEPTH, D_FF, D_MODEL), D_FF ** -0.5),
        'ffn2_w_gu': nrm((DEPTH, D_MODEL, 2 * D_FF), D_MODEL ** -0.5),
        'ffn2_w_down': nrm((DEPTH, D_FF, D_MODEL), D_FF ** -0.5),
        'ab_w_in': nrm((N_EVEN, D_MODEL, IN_AB), D_MODEL ** -0.5),
        'ab_w_out': nrm((N_EVEN, OUT_AB, D_MODEL), OUT_AB ** -0.5),
        'attn_sink': nrm((N_EVEN, N_HEADS), 0.5),
        'conv_w': nrm((N_EVEN, CONV_W, C_CONV), CONV_W ** -0.5),
        'conv_b': nrm((N_EVEN, C_CONV), 0.02),
        'conv_ln_g': 1.0 + nrm((N_EVEN, C_CONV), 0.02),
        'conv_ln_b': nrm((N_EVEN, C_CONV), 0.02),
        'ssm_w_in': nrm((N_ODD, D_MODEL, D_SSM), D_MODEL ** -0.5),
        'ssm_a_re': -0.5 * jnp.exp(nrm((N_ODD, N_GROUPS, SSM_STATE), 0.02)),
        'ssm_a_im': a_im0 + nrm((N_ODD, N_GROUPS, SSM_STATE), 0.01),
        'ssm_log_dt': jax.random.uniform(next(ks), (N_ODD, N_GROUPS), jnp.float32, math.log(1e-3), math.log(1e-1)),
        'ssm_b_re': nrm((N_ODD, N_GROUPS, SSM_STATE, SSM_GROUP), (2 * SSM_GROUP) ** -0.5),
        'ssm_b_im': nrm((N_ODD, N_GROUPS, SSM_STATE, SSM_GROUP), (2 * SSM_GROUP) ** -0.5),
        'ssm_c_re': nrm((N_ODD, N_GROUPS, SSM_GROUP, SSM_STATE), SSM_STATE ** -0.5),
        'ssm_c_im': nrm((N_ODD, N_GROUPS, SSM_GROUP, SSM_STATE), SSM_STATE ** -0.5),
        'ssm_d': nrm((N_ODD, D_SSM), 1.0),
        'ssm_w_glu': nrm((N_ODD, D_SSM, 2 * D_MODEL), D_SSM ** -0.5),
    }


def reference(x_prompt, x_sample, state_conv, cache_win_k, cache_win_v, state_ssm_re, state_ssm_im,
              meta_tokens, norm_g, final_norm_g, ffn1_w_gu, ffn1_w_down, ffn2_w_gu, ffn2_w_down,
              ab_w_in, ab_w_out, attn_sink, conv_w, conv_b, conv_ln_g, conv_ln_b,
              ssm_w_in, ssm_a_re, ssm_a_im, ssm_log_dt, ssm_b_re, ssm_b_im, ssm_c_re, ssm_c_im,
              ssm_d, ssm_w_glu):
    bp = x_prompt.shape[0]
    meta = jnp.broadcast_to(meta_tokens.astype(x_prompt.dtype)[None], (bp, N_META, D_MODEL))
    xp = jnp.concatenate([meta, x_prompt], axis=1)
    xs = x_sample
    pos_p = jnp.arange(xp.shape[1], dtype=jnp.int32)
    pos_s = PAST_LEN + jnp.arange(xs.shape[1], dtype=jnp.int32)
    p_conv, p_k, p_v, p_re, p_im = [], [], [], [], []
    s_conv, s_k, s_v, s_re, s_im = [], [], [], [], []
    for l in range(DEPTH):
        xp = xp + 0.5 * swiglu(rmsnorm(xp, norm_g[l, 0]), ffn1_w_gu[l], ffn1_w_down[l])
        xs = xs + 0.5 * swiglu(rmsnorm(xs, norm_g[l, 0]), ffn1_w_gu[l], ffn1_w_down[l])
        hp = rmsnorm(xp, norm_g[l, 1])
        hs = rmsnorm(xs, norm_g[l, 1])
        i = l // 2
        if l % 2 == 0:
            w = (ab_w_in[i], ab_w_out[i], attn_sink[i], conv_w[i], conv_b[i], conv_ln_g[i], conv_ln_b[i])
            mp, cp, kp, vp = ab_mixer_prompt(hp, pos_p, *w)
            ms, cs, kS, vS = ab_mixer_sample(hs, pos_s, state_conv[i], cache_win_k[i], cache_win_v[i], *w)
            p_conv.append(cp)
            p_k.append(kp)
            p_v.append(vp)
            s_conv.append(cs)
            s_k.append(kS)
            s_v.append(vS)
        else:
            w = (ssm_w_in[i], ssm_a_re[i], ssm_a_im[i], ssm_log_dt[i], ssm_b_re[i], ssm_b_im[i],
                 ssm_c_re[i], ssm_c_im[i], ssm_d[i], ssm_w_glu[i])
            zeros = jnp.zeros((bp, N_GROUPS, SSM_STATE), jnp.float32)
            mp, rp, ip = ssm_mixer(hp, zeros, zeros, *w)
            ms, rS, iS = ssm_mixer(hs, state_ssm_re[i], state_ssm_im[i], *w)
            p_re.append(rp)
            p_im.append(ip)
            s_re.append(rS)
            s_im.append(iS)
        xp = xp + mp
        xs = xs + ms
        xp = xp + 0.5 * swiglu(rmsnorm(xp, norm_g[l, 2]), ffn2_w_gu[l], ffn2_w_down[l])
        xs = xs + 0.5 * swiglu(rmsnorm(xs, norm_g[l, 2]), ffn2_w_gu[l], ffn2_w_down[l])
    y_prompt = rmsnorm(xp, final_norm_g)[:, N_META:]
    y_sample = rmsnorm(xs, final_norm_g)
    return (y_prompt, y_sample,
            jnp.stack(p_conv), jnp.stack(p_k), jnp.stack(p_v), jnp.stack(p_re), jnp.stack(p_im),
            jnp.stack(s_conv), jnp.stack(s_k), jnp.stack(s_v), jnp.stack(s_re), jnp.stack(s_im))
```

```cpp
#include <hip/hip_runtime.h>
#include <hip/hip_cooperative_groups.h>
#include <cstdio>
namespace cg = cooperative_groups;

#ifndef ONLYG
#define ONLYG 0
#endif
#ifndef NOINIT
#define NOINIT 0
#endif
#ifndef NOMIX
#define NOMIX 0
#endif
#ifndef NOSSM
#define NOSSM 0
#endif
#ifndef NOATTN
#define NOATTN 0
#endif
#ifndef NOATTS
#define NOATTS 0
#endif
#ifndef NOCONV
#define NOCONV 0
#endif
#ifndef PROBE_GU
#define PROBE_GU 0
#endif
#ifndef PROBE_INIT
#define PROBE_INIT 0
#endif
#ifndef PROBE_SSM
#define PROBE_SSM 0
#endif
#ifndef PROBE_MIX
#define PROBE_MIX 0
#endif
#ifndef XLO
#define XLO 0
#endif
#ifndef MULTI_LAUNCH
#define MULTI_LAUNCH 0
#endif

#define LAS __attribute__((address_space(3)))
typedef unsigned short bf16_t;
typedef short bf16x8 __attribute__((ext_vector_type(8)));
typedef float f32x4 __attribute__((ext_vector_type(4)));
typedef unsigned u32x2 __attribute__((ext_vector_type(2)));
typedef float f32x2_t __attribute__((ext_vector_type(2)));
typedef unsigned u32x4 __attribute__((ext_vector_type(4)));

constexpr int DM = 1024, SEQL = 4112, NBATCH = 4, TP = NBATCH * SEQL, TS = 128, TT = TP + TS, TPAD = 16640;
constexpr int DFF = 2816;
constexpr int NPHASE = 30;

constexpr size_t O_YP = 0;
constexpr size_t O_YS = O_YP + (size_t)4 * 4096 * 1024;
constexpr size_t O_PCONV = O_YS + 131072;
constexpr size_t O_PK = O_PCONV + 122880;
constexpr size_t O_PV = O_PK + 131072;
constexpr size_t O_PRE = O_PV + 131072;
constexpr size_t O_PIM = O_PRE + 32768;
constexpr size_t O_SCONV = O_PIM + 32768;
constexpr size_t O_SK = O_SCONV + 3932160;
constexpr size_t O_SV = O_SK + 4194304;
constexpr size_t O_SRE = O_SV + 4194304;
constexpr size_t O_SIM = O_SRE + 1048576;

constexpr size_t SZ_GU = (size_t)5632 * 1024 * 2, SZ_DOWN = (size_t)1024 * 2816 * 2, SZ_ABIN = (size_t)1792 * 1024 * 2;
constexpr size_t SZ_SQ = (size_t)1024 * 1024 * 2, SZ_GLU = (size_t)2048 * 1024 * 2;
constexpr size_t W_GU = 0;
constexpr size_t W_DOWN = W_GU + 8 * SZ_GU;
constexpr size_t W_ABIN = W_DOWN + 8 * SZ_DOWN;
constexpr size_t W_ABOUT = W_ABIN + 2 * SZ_ABIN;
constexpr size_t W_SSMIN = W_ABOUT + 2 * SZ_SQ;
constexpr size_t W_GLU = W_SSMIN + 2 * SZ_SQ;
constexpr size_t B_X = W_GLU + 2 * SZ_GLU;
constexpr size_t B_XB = B_X + (size_t)TPAD * 1024 * 4;
constexpr size_t B_SSQ = B_XB + (size_t)TPAD * 1024 * 2;
constexpr size_t B_ROPE = B_SSQ + (size_t)TPAD * 32 * 4;
constexpr size_t B_CAT = B_ROPE + 263424;
constexpr size_t B_HID = B_CAT + (size_t)TPAD * 1024 * 2;
constexpr size_t B_QB = B_HID;
constexpr size_t B_KB = B_QB + (size_t)TPAD * 512 * 2;
constexpr size_t B_VB = B_KB + (size_t)TPAD * 128 * 2;
constexpr size_t B_ZB = B_VB + (size_t)TPAD * 128 * 2;
constexpr size_t B_UF = B_HID;
constexpr size_t B_BAR = B_HID + (size_t)TPAD * 2816 * 2;
constexpr size_t WS_NEED = B_BAR + 16384;

struct P {
  const float* in[31];
  float* out;
  char* ws;
};

__device__ __forceinline__ unsigned pk_bf16(float lo, float hi) {
  unsigned r;
  asm("v_cvt_pk_bf16_f32 %0, %1, %2" : "=v"(r) : "v"(lo), "v"(hi));
  return r;
}
__device__ __forceinline__ float bf2f(unsigned short h) { return __uint_as_float(((unsigned)h) << 16); }
__device__ __forceinline__ u32x2 pk4(f32x4 v) { u32x2 r; r[0] = pk_bf16(v[0], v[1]); r[1] = pk_bf16(v[2], v[3]); return r; }
__device__ __forceinline__ float bfw_lo(unsigned w) { return __uint_as_float(w << 16); }
__device__ __forceinline__ float bfw_hi(unsigned w) { return __uint_as_float(w & 0xffff0000u); }
__device__ __forceinline__ f32x4 hl_join4(u32x2 h, u32x2 l) {
  f32x4 r; r[0] = bfw_lo(h[0]) + bfw_lo(l[0]); r[1] = bfw_hi(h[0]) + bfw_hi(l[0]); r[2] = bfw_lo(h[1]) + bfw_lo(l[1]); r[3] = bfw_hi(h[1]) + bfw_hi(l[1]); return r;
}
__device__ __forceinline__ void hl_split4(f32x4 v, u32x2& h, u32x2& l) {
  h = pk4(v);
  f32x4 hf; hf[0] = bfw_lo(h[0]); hf[1] = bfw_hi(h[0]); hf[2] = bfw_lo(h[1]); hf[3] = bfw_hi(h[1]);
  l = pk4(v - hf);
}
__device__ __forceinline__ float fexp(float x) { return __builtin_amdgcn_exp2f(x * 1.4426950408889634f); }
__device__ __forceinline__ float sigmoidf_(float x) { return __builtin_amdgcn_rcpf(1.f + __builtin_amdgcn_exp2f(x * -1.4426950408889634f)); }
__device__ __forceinline__ float gelu_tanh(float y) {
  const float t = 0.7978845608028654f * (y + 0.044715f * y * y * y);
  const float e = __builtin_amdgcn_exp2f(t * 2.8853900817779268f);
  const float th = 1.f - 2.f * __builtin_amdgcn_rcpf(e + 1.f);
  return 0.5f * y * (1.f + th);
}

__device__ __forceinline__ int lds_byte2(int r, int c) {
  int st = (r >> 4) * 2 + (c >> 5), ob = (r & 15) * 64 + (c & 31) * 2;
  return st * 1024 + (ob ^ (((ob >> 9) & 1) << 5));
}
__device__ __forceinline__ void stage_rc2(int b, int& R, int& C) {
  int st = b >> 10, sb = b & 1023, swz = sb ^ (((sb >> 9) & 1) << 5);
  R = (st / 2) * 16 + swz / 64;
  C = (st % 2) * 32 + (swz % 64) / 2;
}
#define WAIT_V(n) asm volatile("s_waitcnt vmcnt(%0)" ::"n"(n) : "memory")

struct Unit { int pm, pn; };
constexpr int G8_BM = 256, G8_BK = 64, G8_HALF = 128, G8_HTB = G8_HALF * G8_BK * 2;

__device__ __forceinline__ bool unit_next(int i, int nN, int nM, Unit& u) {
  const int nwg = nM * nN;
  const long L = (long)i * gridDim.x + blockIdx.x;
  if (L >= nwg) return false;
  int wgid = (int)L;
  { const int q = nwg / 8, r = nwg % 8, xcd = wgid % 8, off = wgid / 8; wgid = (xcd < r ? xcd * (q + 1) : r * (q + 1) + (xcd - r) * q) + off; }
  const int nig = 8 * nN, gid = wgid / nig, fm = gid * 8, gsz = (nM - fm) < 8 ? (nM - fm) : 8;
  u.pm = fm + ((wgid % nig) % gsz); u.pn = (wgid % nig) / gsz;
  return true;
}

__device__ __forceinline__ void load_rstd(const float* __restrict__ ssq, int pm, int wr, int lane, int fr, float (&rs)[2][4]) {
  const f32x4* sp0 = (const f32x4*)(ssq + (size_t)(pm * 256 + wr * 64 + lane) * 32);
  const f32x4* sp1 = sp0 + 128 * 8;
  f32x4 a = sp0[0], b = sp1[0];
#pragma unroll
  for (int i = 1; i < 8; ++i) { a += sp0[i]; b += sp1[i]; }
  const float r0 = rsqrtf((a[0] + a[1] + a[2] + a[3]) * (1.f / 1024.f) + 1e-6f);
  const float r1 = rsqrtf((b[0] + b[1] + b[2] + b[3]) * (1.f / 1024.f) + 1e-6f);
#pragma unroll
  for (int m = 0; m < 4; ++m) { rs[0][m] = __shfl(r0, m * 16 + fr); rs[1][m] = __shfl(r1, m * 16 + fr); }
}

template <class Epi>
__device__ __forceinline__ void gemm_phase(const bf16_t* __restrict__ Ag, const bf16_t* __restrict__ Btg, int N, int K, const Epi& E, LAS char* lds, int nM = TPAD / G8_BM, const float* __restrict__ ssq_in = nullptr) {
  LAS float* rstd_s = (LAS float*)(lds + 131072);
  int tid = threadIdx.x; asm volatile("" : "+v"(tid));
  const int wid = __builtin_amdgcn_readfirstlane(tid >> 6), lane = tid & 63, wr = wid >> 2, wc = wid & 3, fr = lane & 15, fq = lane >> 4;
  const int nN = N / G8_BM, nt = K / G8_BK;
  unsigned voff[2];
#pragma unroll
  for (int i = 0; i < 2; ++i) { int R, C; stage_rc2(tid * 16 + i * 8192, R, C); voff[i] = (unsigned)(R * K + C) * 2u; }
  const size_t kstep = (size_t)(G8_BK * 2);
  const size_t hstep = (size_t)G8_HALF * K * 2;
  const size_t tstep = 2 * hstep;
  const unsigned ldsw = (unsigned)wid * 1024u;
  const int aoff = lds_byte2(wr * 64 + fr, fq * 8), boff = lds_byte2(wc * 32 + fr, fq * 8);
#define G8_SA(b, h) (((b) * 2 + (h)) * G8_HTB)
#define G8_SB(b, h) ((4 + (b) * 2 + (h)) * G8_HTB)
#define G8_STAGE(bufoff, gbase) do { _Pragma("unroll") for (int _i = 0; _i < 2; ++_i) \
    __builtin_amdgcn_global_load_lds((const unsigned*)((const char*)(gbase) + voff[_i]), (LAS unsigned*)(lds + (bufoff) + ldsw + _i * 8192), 16, 0, 0); } while (0)
#define G8_LDA(dst, b, h) do { _Pragma("unroll") for (int m = 0; m < 4; ++m) _Pragma("unroll") for (int k = 0; k < 2; ++k) dst[m][k] = *(const LAS bf16x8*)(lds + G8_SA(b, h) + aoff + m * 2048 + k * 1024); } while (0)
#define G8_LDB(dst, b, h) do { _Pragma("unroll") for (int n = 0; n < 2; ++n) _Pragma("unroll") for (int k = 0; k < 2; ++k) dst[n][k] = *(const LAS bf16x8*)(lds + G8_SB(b, h) + boff + n * 2048 + k * 1024); } while (0)
#define G8_MMA(ai, bj, At, Bt) do { __builtin_amdgcn_s_setprio(1); _Pragma("unroll") for (int m = 0; m < 4; ++m) _Pragma("unroll") for (int n = 0; n < 2; ++n) _Pragma("unroll") for (int k = 0; k < 2; ++k) \
    acc[ai][bj][m][n] = __builtin_amdgcn_mfma_f32_16x16x32_bf16(Bt[n][k], At[m][k], acc[ai][bj][m][n], 0, 0, 0); __builtin_amdgcn_s_setprio(0); } while (0)
#define G8_WAIT_V(n) asm volatile("s_waitcnt vmcnt(" #n ")" ::: "memory")
#define G8_WAIT_L(n) asm volatile("s_waitcnt lgkmcnt(" #n ")" ::: "memory")
#define G8_BAR __builtin_amdgcn_s_barrier()
#define G8_SCHED __builtin_amdgcn_sched_barrier(0)
  Unit cur, nxt; int ui = 0;
  if (!unit_next(0, nN, nM, cur)) return;
  f32x4 acc[2][2][4][2];
#pragma unroll
  for (int a = 0; a < 2; ++a)
#pragma unroll
    for (int b = 0; b < 2; ++b)
#pragma unroll
      for (int m = 0; m < 4; ++m)
#pragma unroll
        for (int n = 0; n < 2; ++n) acc[a][b][m][n] = (f32x4){0.f, 0.f, 0.f, 0.f};
  bf16x8 At[4][2], B0[2][2], B1[2][2];
  const char* cA = (const char*)Ag + (size_t)cur.pm * tstep; const char* cB = (const char*)Btg + (size_t)cur.pn * tstep;
  f32x4 rp0[8];
  if (Epi::NEED_RSTD && tid < 256) {
    const f32x4* sp = (const f32x4*)(ssq_in + (size_t)(cur.pm * 256 + tid) * 32);
#pragma unroll
    for (int i = 0; i < 8; ++i) rp0[i] = sp[i];
  }
  __syncthreads();
  G8_STAGE(G8_SB(0, 0), cB); G8_STAGE(G8_SA(0, 0), cA); G8_STAGE(G8_SB(0, 1), cB + hstep); G8_STAGE(G8_SA(0, 1), cA + hstep);
  if (Epi::NEED_RSTD && tid < 256) {
    f32x4 a = rp0[0];
#pragma unroll
    for (int i = 1; i < 8; ++i) a += rp0[i];
    rstd_s[tid] = rsqrtf((a[0] + a[1] + a[2] + a[3]) * (1.f / 1024.f) + 1e-6f);
  }
  if (wr == 1) G8_BAR;
  G8_WAIT_V(4); G8_BAR;
  G8_STAGE(G8_SB(1, 0), cB + kstep); G8_STAGE(G8_SA(1, 0), cA + kstep); G8_STAGE(G8_SB(1, 1), cB + hstep + kstep);
  G8_WAIT_V(6); G8_BAR;
  for (;;) {
    const bool has_next = unit_next(ui + 1, nN, nM, nxt);
    const char* nA = has_next ? (const char*)Ag + (size_t)nxt.pm * tstep : cA; const char* nB = has_next ? (const char*)Btg + (size_t)nxt.pn * tstep : cB;
    for (int t = 0; t < nt; t += 2) {
      const bool last = (t == nt - 2);
      const char* a1 = cA + (size_t)(t + 1) * kstep;
      const char* a2 = last ? nA : cA + (size_t)(t + 2) * kstep; const char* b2 = last ? nB : cB + (size_t)(t + 2) * kstep;
      const char* a3 = a2 + kstep; const char* b3 = b2 + kstep;
      G8_LDB(B0, 0, 0); G8_SCHED; G8_LDA(At, 0, 0); G8_STAGE(G8_SA(1, 1), a1 + hstep);
      G8_WAIT_L(8); G8_BAR; G8_WAIT_L(0); G8_MMA(0, 0, At, B0); G8_BAR; G8_SCHED;
      G8_LDB(B1, 0, 1); G8_STAGE(G8_SB(0, 0), b2);
      G8_BAR; G8_WAIT_L(0); G8_MMA(0, 1, At, B1); G8_BAR;
      G8_LDA(At, 0, 1); G8_STAGE(G8_SA(0, 0), a2);
      G8_BAR; G8_WAIT_L(0); G8_MMA(1, 0, At, B0); G8_BAR; G8_SCHED;
      G8_STAGE(G8_SB(0, 1), b2 + hstep);
      G8_WAIT_V(6); G8_BAR; G8_MMA(1, 1, At, B1); G8_BAR;
      G8_LDB(B0, 1, 0); G8_SCHED; G8_LDA(At, 1, 0); G8_STAGE(G8_SA(0, 1), a2 + hstep);
      G8_WAIT_L(8); G8_BAR; G8_WAIT_L(0); G8_MMA(0, 0, At, B0); G8_BAR; G8_SCHED;
      G8_LDB(B1, 1, 1); G8_STAGE(G8_SB(1, 0), b3);
      G8_BAR; G8_WAIT_L(0); G8_MMA(0, 1, At, B1); G8_BAR;
      G8_LDA(At, 1, 1); G8_STAGE(G8_SA(1, 0), a3);
      G8_BAR; G8_WAIT_L(0); G8_MMA(1, 0, At, B0); G8_BAR; G8_SCHED;
      G8_STAGE(G8_SB(1, 1), b3 + hstep);
      G8_WAIT_V(6); G8_BAR; G8_MMA(1, 1, At, B1); G8_BAR;
    }
    {
      f32x4 pf[4];
      const bool do_pf = Epi::NEED_RSTD && has_next;
      if (do_pf) {
        const f32x4* sp = (const f32x4*)(ssq_in + (size_t)(nxt.pm * 256 + (tid >> 1)) * 32 + (tid & 1) * 16);
#pragma unroll
        for (int i = 0; i < 4; ++i) pf[i] = sp[i];
      }
      E(acc, cur, wr, wc, fr, fq, lane, rstd_s + (ui & 1) * 256);
      if (do_pf) {
        const f32x4 a = (pf[0] + pf[1]) + (pf[2] + pf[3]);
        float t_ = (a[0] + a[1]) + (a[2] + a[3]);
        t_ += __shfl_xor(t_, 1);
        if (!(tid & 1)) rstd_s[((ui + 1) & 1) * 256 + (tid >> 1)] = rsqrtf(t_ * (1.f / 1024.f) + 1e-6f);
      }
    }
    if (!has_next) break;
#pragma unroll
    for (int a = 0; a < 2; ++a)
#pragma unroll
      for (int b = 0; b < 2; ++b)
#pragma unroll
        for (int m = 0; m < 4; ++m)
#pragma unroll
          for (int n = 0; n < 2; ++n) acc[a][b][m][n] = (f32x4){0.f, 0.f, 0.f, 0.f};
    cur = nxt; cA = nA; cB = nB; ++ui;
  }
  G8_WAIT_V(0);
  if (wr == 0) G8_BAR;
  G8_BAR;
#undef G8_SA
#undef G8_SB
#undef G8_STAGE
#undef G8_LDA
#undef G8_LDB
#undef G8_MMA
#undef G8_WAIT_V
#undef G8_WAIT_L
#undef G8_BAR
#undef G8_SCHED
}

typedef f32x4 AccT[2][2][4][2];

struct EpiSwiglu {
  static constexpr bool NEED_RSTD = true;
  bf16_t* hid; const float* ssq;
  __device__ __forceinline__ void operator()(const AccT& acc, const Unit& u, int wr, int wc, int fr, int fq, int lane, const LAS float* rsp) const {
    float rs[2][4];
#pragma unroll
    for (int ai = 0; ai < 2; ++ai)
#pragma unroll
      for (int m = 0; m < 4; ++m) rs[ai][m] = rsp[ai * 128 + wr * 64 + m * 16 + fr];
#pragma unroll
    for (int ai = 0; ai < 2; ++ai)
#pragma unroll
      for (int m = 0; m < 4; ++m) {
        __builtin_amdgcn_sched_barrier(0);
        const size_t row = (size_t)u.pm * 256 + ai * 128 + wr * 64 + m * 16 + fr; const float r = rs[ai][m];
        u32x4 w;
#pragma unroll
        for (int bj = 0; bj < 2; ++bj) {
          const f32x4 g = acc[ai][bj][m][0] * r, uu = acc[ai][bj][m][1] * r; f32x4 h;
#pragma unroll
          for (int j = 0; j < 4; ++j) h[j] = g[j] * sigmoidf_(g[j]) * uu[j];
          const u32x2 t_ = pk4(h); w[2 * bj] = t_[0]; w[2 * bj + 1] = t_[1];
        }
        *(u32x4*)(hid + row * DFF + u.pn * 128 + wc * 32 + fq * 8) = w;
      }
  }
};

struct EpiNull {
  static constexpr bool NEED_RSTD = false;
  float* dummy; int never;
  __device__ __forceinline__ void operator()(const AccT& acc, const Unit& u, int wr, int wc, int fr, int fq, int lane, const LAS float* rsp) const {
    if (never) { f32x4 s = acc[0][0][0][0];
#pragma unroll
      for (int a = 0; a < 2; ++a)
#pragma unroll
        for (int b = 0; b < 2; ++b)
#pragma unroll
          for (int m = 0; m < 4; ++m)
#pragma unroll
            for (int n = 0; n < 2; ++n) s += acc[a][b][m][n];
      *(f32x4*)(dummy + lane * 4) = s; }
  }
};

struct EpiResid {
  static constexpr bool NEED_RSTD = false;
  bf16_t* xl; bf16_t* xb; float* ssq; float alpha;
  __device__ __forceinline__ void operator()(const AccT& acc, const Unit& u, int wr, int wc, int fr, int fq, int lane, const LAS float* rsp) const {
#pragma unroll
    for (int ai = 0; ai < 2; ++ai)
#pragma unroll
      for (int m = 0; m < 4; ++m) {
        __builtin_amdgcn_sched_barrier(0);
        const size_t row = (size_t)u.pm * 256 + ai * 128 + wr * 64 + m * 16 + fr;
        float sbj[2];
#pragma unroll
        for (int bj = 0; bj < 2; ++bj) {
          const int c = u.pn * 256 + bj * 128 + wc * 32 + fq * 8;
          const u32x4 hq_ = *(const u32x4*)(xb + row * DM + c), lq_ = XLO ? *(const u32x4*)(xl + row * DM + c) : (u32x4){0u, 0u, 0u, 0u};
          f32x4 x0 = hl_join4((u32x2){hq_[0], hq_[1]}, (u32x2){lq_[0], lq_[1]}), x1 = hl_join4((u32x2){hq_[2], hq_[3]}, (u32x2){lq_[2], lq_[3]});
          x0 += acc[ai][bj][m][0] * alpha; x1 += acc[ai][bj][m][1] * alpha;
          { u32x2 h0, l0, h1, l1; hl_split4(x0, h0, l0); hl_split4(x1, h1, l1);
            *(u32x4*)(xb + row * DM + c) = (u32x4){h0[0], h0[1], h1[0], h1[1]};
            if (XLO) *(u32x4*)(xl + row * DM + c) = (u32x4){l0[0], l0[1], l1[0], l1[1]}; }
          float s0 = x0[0] * x0[0] + x0[1] * x0[1] + x0[2] * x0[2] + x0[3] * x0[3] + x1[0] * x1[0] + x1[1] * x1[1] + x1[2] * x1[2] + x1[3] * x1[3];
          s0 += __shfl_xor(s0, 16); s0 += __shfl_xor(s0, 32);
          sbj[bj] = s0;
        }
        if (fq == 0) *(f32x2_t*)(ssq + row * 32 + u.pn * 8 + wc * 2) = (f32x2_t){sbj[0], sbj[1]};
      }
  }
};

struct EpiResidGlu {
  static constexpr bool NEED_RSTD = false;
  bf16_t* xl; bf16_t* xb; float* ssq;
  __device__ __forceinline__ void operator()(const AccT& acc, const Unit& u, int wr, int wc, int fr, int fq, int lane, const LAS float* rsp) const {
#pragma unroll
    for (int ai = 0; ai < 2; ++ai)
#pragma unroll
      for (int m = 0; m < 4; ++m) {
        __builtin_amdgcn_sched_barrier(0);
        const size_t row = (size_t)u.pm * 256 + ai * 128 + wr * 64 + m * 16 + fr;
        const int c = u.pn * 128 + wc * 32 + fq * 8;
        f32x4 xv[2];
        const u32x4 hq_ = *(const u32x4*)(xb + row * DM + c), lq_ = XLO ? *(const u32x4*)(xl + row * DM + c) : (u32x4){0u, 0u, 0u, 0u};
        xv[0] = hl_join4((u32x2){hq_[0], hq_[1]}, (u32x2){lq_[0], lq_[1]}); xv[1] = hl_join4((u32x2){hq_[2], hq_[3]}, (u32x2){lq_[2], lq_[3]});
#pragma unroll
        for (int bj = 0; bj < 2; ++bj)
#pragma unroll
          for (int j = 0; j < 4; ++j) xv[bj][j] += acc[ai][bj][m][0][j] * sigmoidf_(acc[ai][bj][m][1][j]);
        { u32x2 h0, l0, h1, l1; hl_split4(xv[0], h0, l0); hl_split4(xv[1], h1, l1);
          *(u32x4*)(xb + row * DM + c) = (u32x4){h0[0], h0[1], h1[0], h1[1]};
          if (XLO) *(u32x4*)(xl + row * DM + c) = (u32x4){l0[0], l0[1], l1[0], l1[1]}; }
        float s0 = 0.f;
#pragma unroll
        for (int bj = 0; bj < 2; ++bj) s0 += xv[bj][0] * xv[bj][0] + xv[bj][1] * xv[bj][1] + xv[bj][2] * xv[bj][2] + xv[bj][3] * xv[bj][3];
        s0 += __shfl_xor(s0, 16); s0 += __shfl_xor(s0, 32);
        if (fq == 0) ssq[row * 32 + u.pn * 4 + wc] = s0;
      }
  }
};

struct EpiSsmIn {
  static constexpr bool NEED_RSTD = true;
  bf16_t* uf; const float* ssq;
  __device__ __forceinline__ void operator()(const AccT& acc, const Unit& u, int wr, int wc, int fr, int fq, int lane, const LAS float* rsp) const {
    float rs[2][4];
#pragma unroll
    for (int ai = 0; ai < 2; ++ai)
#pragma unroll
      for (int m = 0; m < 4; ++m) rs[ai][m] = rsp[ai * 128 + wr * 64 + m * 16 + fr];
#pragma unroll
    for (int ai = 0; ai < 2; ++ai)
#pragma unroll
      for (int m = 0; m < 4; ++m) {
        const size_t row = (size_t)u.pm * 256 + ai * 128 + wr * 64 + m * 16 + fr; const float r = rs[ai][m];
#pragma unroll
        for (int bj = 0; bj < 2; ++bj) {
          const int c = u.pn * 256 + bj * 128 + wc * 32 + fq * 8;
          const u32x2 a_ = pk4(acc[ai][bj][m][0] * r), b_ = pk4(acc[ai][bj][m][1] * r);
          *(u32x4*)(uf + row * DM + c) = (u32x4){a_[0], a_[1], b_[0], b_[1]};
        }
      }
  }
};

struct EpiAbIn {
  static constexpr bool NEED_RSTD = true;
  bf16_t *qb, *kb, *vb, *zb; const float* rope; float* out; const float* ssq; int li;
  __device__ __forceinline__ void operator()(const AccT& acc, const Unit& u, int wr, int wc, int fr, int fq0, int lane, const LAS float* rsp) const {
    int fq = fq0; asm volatile("" : "+v"(fq));
    float rs[2][4];
#pragma unroll
    for (int ai = 0; ai < 2; ++ai)
#pragma unroll
      for (int m = 0; m < 4; ++m) rs[ai][m] = rsp[ai * 128 + wr * 64 + m * 16 + fr];
#pragma unroll
    for (int ai = 0; ai < 2; ++ai)
#pragma unroll
      for (int m = 0; m < 4; ++m) {
        __builtin_amdgcn_sched_barrier(0);
        const int row = u.pm * 256 + ai * 128 + wr * 64 + m * 16 + fr; const float r = rs[ai][m];
        const bool is_p = row < TP, is_s = (row >= TP) && (row < TT);
        int b = 0, pos = 8192, pidx = SEQL;
        if (is_p) { b = row / SEQL; pos = row - b * SEQL; pidx = pos; } else if (is_s) { b = row - TP; }
        if (u.pn < 3) {
#pragma unroll
          for (int bj = 0; bj < 2; ++bj) {
            const bool isv = (u.pn == 2) && (bj == 1);
            f32x4 v0 = acc[ai][bj][m][0] * r, v1 = acc[ai][bj][m][1] * r;
            if (!isv && ((wc & 1) == 0)) {
              f32x4 o0, o1;
#pragma unroll
              for (int j = 0; j < 4; ++j) { o0[j] = __shfl_xor(v0[j], 16); o1[j] = __shfl_xor(v1[j], 16); }
              const f32x4 c0 = *(const f32x4*)(rope + pidx * 16), c1 = *(const f32x4*)(rope + pidx * 16 + 4);
              const f32x4 s0 = *(const f32x4*)(rope + pidx * 16 + 8), s1 = *(const f32x4*)(rope + pidx * 16 + 12);
              if (fq == 0) { v0 = v0 * c0 - o0 * s0; v1 = v1 * c1 - o1 * s1; }
              else if (fq == 1) { v0 = v0 * c0 + o0 * s0; v1 = v1 * c1 + o1 * s1; }
            }
            u32x4 w; { const u32x2 a_ = pk4(v0), b_ = pk4(v1); w[0] = a_[0]; w[1] = a_[1]; w[2] = b_[0]; w[3] = b_[1]; }
            if (u.pn < 2) {
              *(u32x4*)(qb + (size_t)row * 512 + u.pn * 256 + bj * 128 + wc * 32 + fq * 8) = w;
            } else {
              const int kvh = wc >> 1, d0 = (wc & 1) * 32 + fq * 8;
              *(u32x4*)((isv ? vb : kb) + (size_t)row * 128 + kvh * 64 + d0) = w;
              if (is_p && pos >= SEQL - 128) {
                float* o = out + (isv ? O_PV : O_PK) + ((size_t)((li * 4 + b) * 128 + (pos - (SEQL - 128))) * 2 + kvh) * 64 + d0;
                *(f32x4*)(o) = v0; *(f32x4*)(o + 4) = v1;
              }
              if (is_s) {
                float* o = out + (isv ? O_SV : O_SK) + ((size_t)((li * 128 + b) * 128 + 127) * 2 + kvh) * 64 + d0;
                *(f32x4*)(o) = v0; *(f32x4*)(o + 4) = v1;
              }
            }
          }
        } else {
          f32x4 z[2];
#pragma unroll
          for (int bj = 0; bj < 2; ++bj)
#pragma unroll
            for (int j = 0; j < 4; ++j) z[bj][j] = acc[ai][bj][m][0][j] * r * sigmoidf_(acc[ai][bj][m][1][j] * r);
          const int zc = (u.pn - 3) * 128 + wc * 32 + fq * 8;
          u32x4 w; { const u32x2 a_ = pk4(z[0]), b_ = pk4(z[1]); w[0] = a_[0]; w[1] = a_[1]; w[2] = b_[0]; w[3] = b_[1]; }
          *(u32x4*)(zb + (size_t)row * 512 + zc) = w;
          if (is_p && pos >= SEQL - 30) { float* o = out + O_PCONV + ((size_t)(li * 4 + b) * 30 + (pos - (SEQL - 30))) * 512 + zc; *(f32x4*)o = z[0]; *(f32x4*)(o + 4) = z[1]; }
          if (is_s) { float* o = out + O_SCONV + ((size_t)(li * 128 + b) * 30 + 29) * 512 + zc; *(f32x4*)o = z[0]; *(f32x4*)(o + 4) = z[1]; }
        }
      }
  }
};


__device__ __forceinline__ int wt_row_of_col(int c) { const int c32 = c & 31; return (c & ~31) + 16 * ((c32 >> 2) & 1) + 4 * (c32 >> 3) + (c32 & 3); }

struct MiniResid {
  bf16_t* xl; bf16_t* xb; float* ssq; float alpha;
  __device__ __forceinline__ void operator()(int row, int c0, int fq, const f32x4 (&v)[2]) const {
    float s0 = 0.f;
#pragma unroll
    for (int ct = 0; ct < 2; ++ct) {
      const int c = c0 + 16 * ct + 4 * fq;
      f32x4 xv = hl_join4(*(const u32x2*)(xb + (size_t)row * DM + c), XLO ? *(const u32x2*)(xl + (size_t)row * DM + c) : (u32x2){0u, 0u});
      xv += v[ct] * alpha;
      { u32x2 h_, l_; hl_split4(xv, h_, l_); *(u32x2*)(xb + (size_t)row * DM + c) = h_; if (XLO) *(u32x2*)(xl + (size_t)row * DM + c) = l_; }
      s0 += xv[0] * xv[0] + xv[1] * xv[1] + xv[2] * xv[2] + xv[3] * xv[3];
    }
    s0 += __shfl_xor(s0, 16); s0 += __shfl_xor(s0, 32);
    if (fq == 0) ssq[(size_t)row * 32 + (c0 >> 5)] = s0;
  }
};
struct MiniSsmIn {
  bf16_t* uf; const float* ssq;
  __device__ __forceinline__ void operator()(int row, int c0, int fq, const f32x4 (&v)[2]) const {
    const f32x4* sp = (const f32x4*)(ssq + (size_t)row * 32);
    f32x4 a = sp[0];
#pragma unroll
    for (int i = 1; i < 8; ++i) a += sp[i];
    const float r = rsqrtf((a[0] + a[1] + a[2] + a[3]) * (1.f / 1024.f) + 1e-6f);
#pragma unroll
    for (int ct = 0; ct < 2; ++ct) *(u32x2*)(uf + (size_t)row * DM + c0 + 16 * ct + 4 * fq) = pk4(v[ct] * r);
  }
};

template <class ME>
__device__ __forceinline__ void mini_phase(const bf16_t* __restrict__ A, const bf16_t* __restrict__ Bt, int K, const ME& me, char* shm) {
  int tid = threadIdx.x; asm volatile("" : "+v"(tid));
  const int wave = tid >> 6, lane = tid & 63, fr = lane & 15, fq = lane >> 4;
  float* red = (float*)shm;
  for (int mu = blockIdx.x; mu < 96; mu += gridDim.x) {
    const int rg = mu >> 5, cgi = mu & 31, r0 = 16384 + rg * 64, c0 = cgi * 32;
    const int kw = K >> 3, kb = wave * kw;
    f32x4 acc[4][2];
#pragma unroll
    for (int mt = 0; mt < 4; ++mt) { acc[mt][0] = (f32x4){0.f, 0.f, 0.f, 0.f}; acc[mt][1] = (f32x4){0.f, 0.f, 0.f, 0.f}; }
    const bf16_t* ap = A + (size_t)(r0 + fr) * K + kb + fq * 8;
    const bf16_t* bp0 = Bt + (size_t)wt_row_of_col(c0 + fr) * K + kb + fq * 8;
    const bf16_t* bp1 = Bt + (size_t)wt_row_of_col(c0 + 16 + fr) * K + kb + fq * 8;
    const int nks = kw >> 5;
#pragma unroll 4
    for (int ks = 0; ks < nks; ++ks) {
      const bf16x8 b0 = *(const bf16x8*)(bp0 + ks * 32), b1 = *(const bf16x8*)(bp1 + ks * 32);
#pragma unroll
      for (int mt = 0; mt < 4; ++mt) {
        const bf16x8 a = *(const bf16x8*)(ap + (size_t)mt * 16 * K + ks * 32);
        acc[mt][0] = __builtin_amdgcn_mfma_f32_16x16x32_bf16(b0, a, acc[mt][0], 0, 0, 0);
        acc[mt][1] = __builtin_amdgcn_mfma_f32_16x16x32_bf16(b1, a, acc[mt][1], 0, 0, 0);
      }
    }
    __syncthreads();
#pragma unroll
    for (int mt = 0; mt < 4; ++mt)
#pragma unroll
      for (int ct = 0; ct < 2; ++ct) *(f32x4*)(red + ((wave * 8 + mt * 2 + ct) * 64 + lane) * 4) = acc[mt][ct];
    __syncthreads();
    if (wave < 4) {
      f32x4 v[2];
#pragma unroll
      for (int ct = 0; ct < 2; ++ct) {
        f32x4 t = *(const f32x4*)(red + ((wave * 2 + ct) * 64 + lane) * 4);
#pragma unroll
        for (int w = 1; w < 8; ++w) t += *(const f32x4*)(red + ((w * 8 + wave * 2 + ct) * 64 + lane) * 4);
        v[ct] = t;
      }
      me(r0 + 16 * wave + fr, c0, fq, v);
    }
  }
}


__device__ __forceinline__ int wt_row_glu(int n, int H) {
  const int t = H >> 7, h7 = H & 127;
  return 256 * t + 128 * ((h7 >> 2) & 1) + 32 * (h7 >> 5) + 16 * n + 4 * ((h7 >> 3) & 3) + (h7 & 3);
}
__device__ __forceinline__ void mini_glu_phase(const bf16_t* __restrict__ A, const bf16_t* __restrict__ Bt, bf16_t* xl, bf16_t* xb, float* ssq, char* shm) {
  constexpr int K = 1024;
  int tid = threadIdx.x; asm volatile("" : "+v"(tid));
  const int wave = tid >> 6, lane = tid & 63, fr = lane & 15, fq = lane >> 4;
  float* red = (float*)shm;
  for (int mu = blockIdx.x; mu < 96; mu += gridDim.x) {
    const int rg = mu >> 5, cgi = mu & 31, r0 = 16384 + rg * 64, H0 = cgi * 32;
    const int kb = wave * (K / 8);
    f32x4 acc[4][2][2];
#pragma unroll
    for (int mt = 0; mt < 4; ++mt)
#pragma unroll
      for (int ct = 0; ct < 2; ++ct) { acc[mt][ct][0] = (f32x4){0.f, 0.f, 0.f, 0.f}; acc[mt][ct][1] = (f32x4){0.f, 0.f, 0.f, 0.f}; }
    const bf16_t* ap = A + (size_t)(r0 + fr) * K + kb + fq * 8;
    const bf16_t* bp[2][2];
#pragma unroll
    for (int ct = 0; ct < 2; ++ct)
#pragma unroll
      for (int n = 0; n < 2; ++n) bp[ct][n] = Bt + (size_t)wt_row_glu(n, H0 + 16 * ct + fr) * K + kb + fq * 8;
#pragma unroll
    for (int ks = 0; ks < 4; ++ks) {
      bf16x8 bf[2][2];
#pragma unroll
      for (int ct = 0; ct < 2; ++ct)
#pragma unroll
        for (int n = 0; n < 2; ++n) bf[ct][n] = *(const bf16x8*)(bp[ct][n] + ks * 32);
#pragma unroll
      for (int mt = 0; mt < 4; ++mt) {
        const bf16x8 a = *(const bf16x8*)(ap + (size_t)mt * 16 * K + ks * 32);
#pragma unroll
        for (int ct = 0; ct < 2; ++ct)
#pragma unroll
          for (int n = 0; n < 2; ++n) acc[mt][ct][n] = __builtin_amdgcn_mfma_f32_16x16x32_bf16(bf[ct][n], a, acc[mt][ct][n], 0, 0, 0);
      }
    }
    __syncthreads();
#pragma unroll
    for (int mt = 0; mt < 4; ++mt)
#pragma unroll
      for (int ct = 0; ct < 2; ++ct)
#pragma unroll
        for (int n = 0; n < 2; ++n) *(f32x4*)(red + ((wave * 16 + mt * 4 + ct * 2 + n) * 64 + lane) * 4) = acc[mt][ct][n];
    __syncthreads();
    if (wave < 4) {
      const int row = r0 + 16 * wave + fr;
      float s0 = 0.f;
#pragma unroll
      for (int ct = 0; ct < 2; ++ct) {
        f32x4 val = (f32x4){0.f, 0.f, 0.f, 0.f}, gate = (f32x4){0.f, 0.f, 0.f, 0.f};
#pragma unroll
        for (int w = 0; w < 8; ++w) {
          val += *(const f32x4*)(red + ((w * 16 + wave * 4 + ct * 2 + 0) * 64 + lane) * 4);
          gate += *(const f32x4*)(red + ((w * 16 + wave * 4 + ct * 2 + 1) * 64 + lane) * 4);
        }
        const int c = H0 + 16 * ct + 4 * fq;
        f32x4 xv = hl_join4(*(const u32x2*)(xb + (size_t)row * DM + c), XLO ? *(const u32x2*)(xl + (size_t)row * DM + c) : (u32x2){0u, 0u});
#pragma unroll
        for (int j = 0; j < 4; ++j) xv[j] += val[j] * sigmoidf_(gate[j]);
        { u32x2 h_, l_; hl_split4(xv, h_, l_); *(u32x2*)(xb + (size_t)row * DM + c) = h_; if (XLO) *(u32x2*)(xl + (size_t)row * DM + c) = l_; }
        s0 += xv[0] * xv[0] + xv[1] * xv[1] + xv[2] * xv[2] + xv[3] * xv[3];
      }
      s0 += __shfl_xor(s0, 16); s0 += __shfl_xor(s0, 32);
      if (fq == 0) ssq[(size_t)row * 32 + cgi] = s0;
    }
  }
}

__device__ __forceinline__ int src_col(int R, int start, int lo, int hi) {
  if (R >= start) {
    const int rp = R - start, t = rp >> 8, cl = rp & 255;
    const int bj = cl >> 7, wc = (cl >> 5) & 3, n = (cl >> 4) & 1, fq = (cl >> 2) & 3, j = cl & 3;
    return (n ? hi : lo) + 128 * t + 32 * wc + 8 * fq + 4 * bj + j;
  }
  const int cl = R & 31, n = cl >> 4, i = cl & 15;
  return (R & ~31) + 8 * (i >> 2) + 4 * n + (i & 3);
}

__device__ __forceinline__ void convert_mat(const float* __restrict__ src, bf16_t* __restrict__ dst, int K, int N,
                                            int start, int lo, int hi, const float* __restrict__ gvec, float* tile) {
  const int ntk = K / 64, ntn = N / 64, ntile = ntk * ntn;
  const int tid = threadIdx.x;
  const int q = tid & 15, kq = tid >> 4;
  const int n = tid >> 3, k8 = (tid & 7) * 8;
  f32x4 v0, v1; float g0 = 1.f, g1 = 1.f;
  int tI = blockIdx.x;
  if (tI < ntile) {
    const int tn = tI / ntk, tk = tI % ntk, col = src_col(tn * 64 + 4 * q, start, lo, hi), k = tk * 64 + kq;
    v0 = *(const f32x4*)(src + (size_t)k * N + col); v1 = *(const f32x4*)(src + (size_t)(k + 32) * N + col);
    if (gvec) { g0 = gvec[k]; g1 = gvec[k + 32]; }
  }
  for (; tI < ntile; tI += gridDim.x) {
    const int tn = tI / ntk, tk = tI % ntk, r0 = tn * 64, k0 = tk * 64;
    const f32x4 c0 = v0 * g0, c1 = v1 * g1;
    const int tN = tI + gridDim.x;
    if (tN < ntile) {
      const int tn2 = tN / ntk, tk2 = tN % ntk, col = src_col(tn2 * 64 + 4 * q, start, lo, hi), k = tk2 * 64 + kq;
      v0 = *(const f32x4*)(src + (size_t)k * N + col); v1 = *(const f32x4*)(src + (size_t)(k + 32) * N + col);
      if (gvec) { g0 = gvec[k]; g1 = gvec[k + 32]; }
    }
    { float* tp = tile + kq * 65 + 4 * q; tp[0] = c0[0]; tp[1] = c0[1]; tp[2] = c0[2]; tp[3] = c0[3];
      tp += 32 * 65; tp[0] = c1[0]; tp[1] = c1[1]; tp[2] = c1[2]; tp[3] = c1[3]; }
    __syncthreads();
    {
      u32x4 w;
#pragma unroll
      for (int i = 0; i < 4; ++i) w[i] = pk_bf16(tile[(k8 + 2 * i) * 65 + n], tile[(k8 + 2 * i + 1) * 65 + n]);
      *(u32x4*)(dst + (size_t)(r0 + n) * K + k0 + k8) = w;
    }
    __syncthreads();
  }
}

__device__ __forceinline__ void phase_init(const P& p, float* tile) {
  const int wave = threadIdx.x >> 6, lane = threadIdx.x & 63;
  bf16_t* xl = (bf16_t*)(p.ws + B_X); bf16_t* xb = (bf16_t*)(p.ws + B_XB); float* ssq = (float*)(p.ws + B_SSQ);
  float* rope = (float*)(p.ws + B_ROPE);
  for (int row = blockIdx.x * 8 + wave; row < TPAD; row += gridDim.x * 8) {
    const float* src = nullptr;
    if (row < TP) { const int b = row / SEQL, pos = row - b * SEQL; src = (pos < 16) ? (p.in[7] + pos * DM) : (p.in[0] + ((size_t)b * 4096 + (pos - 16)) * DM); }
    else if (row < TT) src = p.in[1] + (size_t)(row - TP) * DM;
    float ss = 0.f;
#pragma unroll
    for (int i = 0; i < 4; ++i) {
      const int c = (i * 64 + lane) * 4;
      f32x4 v = (f32x4){0.f, 0.f, 0.f, 0.f};
      if (src) v = *(const f32x4*)(src + c);
      { u32x2 h_, l_; hl_split4(v, h_, l_); *(u32x2*)(xb + (size_t)row * DM + c) = h_; if (XLO) *(u32x2*)(xl + (size_t)row * DM + c) = l_; }
      ss += v[0] * v[0] + v[1] * v[1] + v[2] * v[2] + v[3] * v[3];
    }
    ss += __shfl_xor(ss, 1);
    if (!(lane & 1)) ssq[(size_t)row * 32 + (lane >> 1)] = ss;
  }
  for (int e = blockIdx.x * 512 + threadIdx.x; e < 4113 * 8; e += gridDim.x * 512) {
    const int pi = e >> 3, j = e & 7;
    const double inv[8] = {1.0, 0.19392274474868576, 0.03760603093086393, 0.007292664737217109,
                           0.001414213562373095, 0.0002742481756762073, 5.318295896944988e-05, 1.031338537721246e-05};
    double iv = inv[0];
#pragma unroll
    for (int q = 1; q < 8; ++q) iv = (j == q) ? inv[q] : iv;
    const double pos = (pi == SEQL) ? 8192.0 : (double)pi;
    const double ang = pos * iv;
    const double n = __builtin_rint(ang * 0.15915494309189535);
    const float rf = (float)(ang - n * 6.283185307179586);
    rope[pi * 16 + j] = cosf(rf);
    rope[pi * 16 + 8 + j] = sinf(rf);
  }
  const float* ng = p.in[8];
  for (int l = 0; l < 4; ++l) {
    convert_mat(p.in[10] + (size_t)l * 1024 * 5632, (bf16_t*)(p.ws + W_GU + (size_t)(l * 2 + 0) * SZ_GU), 1024, 5632, 0, 0, 2816, ng + (l * 3 + 0) * 1024, tile);
    convert_mat(p.in[12] + (size_t)l * 1024 * 5632, (bf16_t*)(p.ws + W_GU + (size_t)(l * 2 + 1) * SZ_GU), 1024, 5632, 0, 0, 2816, ng + (l * 3 + 2) * 1024, tile);
    convert_mat(p.in[11] + (size_t)l * 2816 * 1024, (bf16_t*)(p.ws + W_DOWN + (size_t)(l * 2 + 0) * SZ_DOWN), 2816, 1024, 1 << 30, 0, 0, nullptr, tile);
    convert_mat(p.in[13] + (size_t)l * 2816 * 1024, (bf16_t*)(p.ws + W_DOWN + (size_t)(l * 2 + 1) * SZ_DOWN), 2816, 1024, 1 << 30, 0, 0, nullptr, tile);
    const int i = l >> 1;
    if ((l & 1) == 0) {
      convert_mat(p.in[14] + (size_t)i * 1024 * 1792, (bf16_t*)(p.ws + W_ABIN + (size_t)i * SZ_ABIN), 1024, 1792, 768, 768, 1280, ng + (l * 3 + 1) * 1024, tile);
      convert_mat(p.in[15] + (size_t)i * 1024 * 1024, (bf16_t*)(p.ws + W_ABOUT + (size_t)i * SZ_SQ), 1024, 1024, 1 << 30, 0, 0, nullptr, tile);
    } else {
      convert_mat(p.in[21] + (size_t)i * 1024 * 1024, (bf16_t*)(p.ws + W_SSMIN + (size_t)i * SZ_SQ), 1024, 1024, 1 << 30, 0, 0, ng + (l * 3 + 1) * 1024, tile);
      convert_mat(p.in[30] + (size_t)i * 1024 * 2048, (bf16_t*)(p.ws + W_GLU + (size_t)i * SZ_GLU), 1024, 2048, 0, 0, 1024, nullptr, tile);
    }
  }
}

__device__ __forceinline__ void phase_final(const P& p) {
  const int wave = threadIdx.x >> 6, lane = threadIdx.x & 63;
  const bf16_t* xl = (const bf16_t*)(p.ws + B_X); const bf16_t* xb = (const bf16_t*)(p.ws + B_XB); const float* ssq = (const float*)(p.ws + B_SSQ);
  const float* g = p.in[9];
  for (int row = blockIdx.x * 8 + wave; row < TT; row += gridDim.x * 8) {
    float* dst;
    if (row < TP) { const int b = row / SEQL, pos = row - b * SEQL; if (pos < 16) continue; dst = p.out + O_YP + ((size_t)b * 4096 + (pos - 16)) * DM; }
    else dst = p.out + O_YS + (size_t)(row - TP) * DM;
    float s = (lane < 32) ? ssq[(size_t)row * 32 + lane] : 0.f;
#pragma unroll
    for (int o = 32; o >= 1; o >>= 1) s += __shfl_xor(s, o);
    const float r = rsqrtf(s * (1.f / 1024.f) + 1e-6f);
#pragma unroll
    for (int i = 0; i < 4; ++i) {
      const int c = (i * 64 + lane) * 4;
      f32x4 v = hl_join4(*(const u32x2*)(xb + (size_t)row * DM + c), XLO ? *(const u32x2*)(xl + (size_t)row * DM + c) : (u32x2){0u, 0u});
      const f32x4 gg = *(const f32x4*)(g + c);
      *(f32x4*)(dst + c) = v * r * gg;
    }
  }
}

constexpr int VST = 164;

__device__ __forceinline__ void phase_mix_ab(const P& p, int li, char* shm) {
  int tid = threadIdx.x; asm volatile("" : "+v"(tid));
  const int wave = tid >> 6, lane = tid & 63, fr = lane & 15, fq = lane >> 4;
  const bf16_t* qb = (const bf16_t*)(p.ws + B_QB); const bf16_t* kb = (const bf16_t*)(p.ws + B_KB);
  const bf16_t* vb = (const bf16_t*)(p.ws + B_VB); const bf16_t* zb = (const bf16_t*)(p.ws + B_ZB);
  bf16_t* cat = (bf16_t*)(p.ws + B_CAT);
  const float* sinkp = p.in[16] + li * 8;
  constexpr int NU_AP = 4 * 129, NU_AS = 128, NU_CP = 4 * 129, NU_CS = 32;
  constexpr int NU = NU_AP + NU_AS + NU_CP + NU_CS;
  for (int unit0 = blockIdx.x; unit0 < NU; unit0 += gridDim.x) {
    __syncthreads();
    auto xcd_run = [](int a, int n) { const int q = n >> 3, r = n & 7, x = a & 7, off = a >> 3; return (x < r ? x * (q + 1) : r * (q + 1) + (x - r) * q) + off; };
    const int unit = (unit0 < NU_AS) ? (NU_AP + unit0) : (unit0 < NU_AS + NU_CS) ? (NU_AP + NU_AS + NU_CP + (unit0 - NU_AS)) : (unit0 < NU_AS + NU_CS + NU_AP) ? xcd_run(unit0 - NU_AS - NU_CS, NU_AP) : (NU_AP + NU_AS + xcd_run(unit0 - NU_AS - NU_CS - NU_AP, NU_CP));
    if (unit < NU_AP) {
#if !NOATTN
      const int b = unit / 129, qt = unit % 129, q0 = qt * 32, k0 = q0 - 128;
      bf16_t* Vt = (bf16_t*)shm;
      const int hq = wave, kvh = hq >> 2;
      const float sink = sinkp[hq];
      u32x4 vreg[5];
#pragma unroll
      for (int it = 0; it < 5; ++it) {
        const int idx = it * 512 + tid, key = idx >> 4, dc = (idx & 15) * 8, kp = k0 + key;
        vreg[it] = (u32x4){0u, 0u, 0u, 0u};
        if (kp >= 0 && kp < SEQL) vreg[it] = *(const u32x4*)(vb + (size_t)(b * SEQL + kp) * 128 + dc);
      }
      bf16x8 Qf[2][2];
#pragma unroll
      for (int q2 = 0; q2 < 2; ++q2) {
        const int qp = min(q0 + 16 * q2 + fr, SEQL - 1);
#pragma unroll
        for (int kk = 0; kk < 2; ++kk) Qf[q2][kk] = *(const bf16x8*)(qb + (size_t)(b * SEQL + qp) * 512 + hq * 64 + kk * 32 + fq * 8);
      }
      bf16x8 Kf[5][2];
#pragma unroll
      for (int kt = 0; kt < 5; ++kt) {
        const int kp = min(max(k0 + 16 * kt + fr, 0), SEQL - 1);
        const bf16_t* kr = kb + (size_t)(b * SEQL + kp) * 128 + kvh * 64 + fq * 8;
        Kf[kt][0] = *(const bf16x8*)(kr); Kf[kt][1] = *(const bf16x8*)(kr + 32);
      }
#pragma unroll
      for (int it = 0; it < 5; ++it) {
        const int idx = it * 512 + tid, key = idx >> 4, dc = (idx & 15) * 8;
        const u32x4 v = vreg[it];
#pragma unroll
        for (int e = 0; e < 4; ++e) {
          Vt[(dc + 2 * e) * VST + key] = (bf16_t)(v[e] & 0xffff);
          Vt[(dc + 2 * e + 1) * VST + key] = (bf16_t)(v[e] >> 16);
        }
      }
      __syncthreads();
      f32x4 s[10][2];
#pragma unroll
      for (int kt = 0; kt < 10; ++kt) {
        bf16x8 K0, K1;
        if (kt < 5) { K0 = Kf[kt % 5][0]; K1 = Kf[kt % 5][1]; }
        else {
          const int kp = min(max(k0 + 16 * kt + fr, 0), SEQL - 1);
          const bf16_t* kr = kb + (size_t)(b * SEQL + kp) * 128 + kvh * 64 + fq * 8;
          K0 = *(const bf16x8*)(kr); K1 = *(const bf16x8*)(kr + 32);
        }
#pragma unroll
        for (int q2 = 0; q2 < 2; ++q2) {
          f32x4 a = (f32x4){0.f, 0.f, 0.f, 0.f};
          a = __builtin_amdgcn_mfma_f32_16x16x32_bf16(K0, Qf[q2][0], a, 0, 0, 0);
          a = __builtin_amdgcn_mfma_f32_16x16x32_bf16(K1, Qf[q2][1], a, 0, 0, 0);
          s[kt][q2] = a;
        }
      }
      float invl[2];
#pragma unroll
      for (int q2 = 0; q2 < 2; ++q2) {
        const int qp = q0 + 16 * q2 + fr;
        float mx = sink;
#pragma unroll
        for (int kt = 0; kt < 10; ++kt)
#pragma unroll
          for (int j = 0; j < 4; ++j) {
            const int kp = k0 + 16 * kt + 4 * fq + j, diff = qp - kp;
            const bool valid = (kp >= 0) && (diff >= 0) && (diff <= 128);
            const float sc = valid ? s[kt][q2][j] * 0.125f : -1e30f;
            s[kt][q2][j] = sc;
            mx = fmaxf(mx, sc);
          }
        mx = fmaxf(mx, __shfl_xor(mx, 16)); mx = fmaxf(mx, __shfl_xor(mx, 32));
        float l = 0.f;
#pragma unroll
        for (int kt = 0; kt < 10; ++kt)
#pragma unroll
          for (int j = 0; j < 4; ++j) {
            const float sc = s[kt][q2][j];
            const float pv = (sc > -1e29f) ? fexp(sc - mx) : 0.f;
            s[kt][q2][j] = pv; l += pv;
          }
        l += __shfl_xor(l, 16); l += __shfl_xor(l, 32);
        l += fexp(sink - mx);
        invl[q2] = 1.f / l;
      }
      f32x4 o[4][2];
#pragma unroll
      for (int dt = 0; dt < 4; ++dt)
#pragma unroll
        for (int q2 = 0; q2 < 2; ++q2) o[dt][q2] = (f32x4){0.f, 0.f, 0.f, 0.f};
#pragma unroll
      for (int ks = 0; ks < 5; ++ks) {
        bf16x8 Pf[2];
#pragma unroll
        for (int q2 = 0; q2 < 2; ++q2) {
          u32x4 w;
          w[0] = pk_bf16(s[2 * ks][q2][0], s[2 * ks][q2][1]); w[1] = pk_bf16(s[2 * ks][q2][2], s[2 * ks][q2][3]);
          w[2] = pk_bf16(s[2 * ks + 1][q2][0], s[2 * ks + 1][q2][1]); w[3] = pk_bf16(s[2 * ks + 1][q2][2], s[2 * ks + 1][q2][3]);
          Pf[q2] = __builtin_bit_cast(bf16x8, w);
        }
#pragma unroll
        for (int dt = 0; dt < 4; ++dt) {
          const int d = kvh * 64 + 16 * dt + fr;
          const u32x2 v0 = *(const u32x2*)(Vt + d * VST + 32 * ks + 4 * fq);
          const u32x2 v1 = *(const u32x2*)(Vt + d * VST + 32 * ks + 16 + 4 * fq);
          u32x4 w; w[0] = v0[0]; w[1] = v0[1]; w[2] = v1[0]; w[3] = v1[1];
          const bf16x8 Vf = __builtin_bit_cast(bf16x8, w);
#pragma unroll
          for (int q2 = 0; q2 < 2; ++q2) o[dt][q2] = __builtin_amdgcn_mfma_f32_16x16x32_bf16(Vf, Pf[q2], o[dt][q2], 0, 0, 0);
        }
      }
      int fr2 = fr, fq2 = fq; asm volatile("" : "+v"(fr2), "+v"(fq2));
#pragma unroll
      for (int q2 = 0; q2 < 2; ++q2) {
        const int qp = q0 + 16 * q2 + fr2;
        if (qp < SEQL) {
          bf16_t* dst = cat + (size_t)(b * SEQL + qp) * 1024 + hq * 64 + 4 * fq2;
#pragma unroll
          for (int dt = 0; dt < 4; ++dt) *(u32x2*)(dst + 16 * dt) = pk4(o[dt][q2] * invl[q2]);
        }
      }
#endif
    } else if (unit < NU_AP + NU_AS) {
#if !NOATTS
      const int sb = unit - NU_AP, hq = wave, kvh = hq >> 2;
      float* qs = (float*)shm + wave * 256;
      float* ps = qs + 64;
      const float* ck = p.in[3] + (size_t)(li * 128 + sb) * 128 * 128;
      const float* cv = p.in[4] + (size_t)(li * 128 + sb) * 128 * 128;
      float* ok = p.out + O_SK + (size_t)(li * 128 + sb) * 128 * 128;
      float* ov = p.out + O_SV + (size_t)(li * 128 + sb) * 128 * 128;
      qs[lane] = bf2f(qb[(size_t)(TP + sb) * 512 + hq * 64 + lane]);
      asm volatile("" ::: "memory");
      const float sink = sinkp[hq];
      float s0, s1, s2;
      {
        const float* kr0 = ck + (size_t)lane * 128 + kvh * 64;
        const float* kr1 = kr0 + 64 * 128;
        float a0 = 0.f, a1 = 0.f;
#pragma unroll
        for (int d4 = 0; d4 < 16; ++d4) {
          const f32x4 k0 = *(const f32x4*)(kr0 + d4 * 4), k1 = *(const f32x4*)(kr1 + d4 * 4);
          const f32x4 qv = *(const f32x4*)(qs + d4 * 4);
          a0 += k0[0] * qv[0] + k0[1] * qv[1] + k0[2] * qv[2] + k0[3] * qv[3];
          a1 += k1[0] * qv[0] + k1[1] * qv[1] + k1[2] * qv[2] + k1[3] * qv[3];
        }
        const f32x4 kn = *(const f32x4*)(ok + (size_t)127 * 128 + kvh * 64 + (lane & 15) * 4);
        const f32x4 qn = *(const f32x4*)(qs + (lane & 15) * 4);
        float a2 = kn[0] * qn[0] + kn[1] * qn[1] + kn[2] * qn[2] + kn[3] * qn[3];
        a2 += __shfl_xor(a2, 8); a2 += __shfl_xor(a2, 4); a2 += __shfl_xor(a2, 2); a2 += __shfl_xor(a2, 1);
        s0 = a0 * 0.125f; s1 = a1 * 0.125f; s2 = (lane == 0) ? a2 * 0.125f : -1e30f;
      }
      float mx = fmaxf(fmaxf(s0, s1), fmaxf(s2, sink));
#pragma unroll
      for (int o = 32; o >= 1; o >>= 1) mx = fmaxf(mx, __shfl_xor(mx, o));
      const float p0 = fexp(s0 - mx), p1 = fexp(s1 - mx), p2 = (lane == 0) ? fexp(s2 - mx) : 0.f;
      ps[lane] = p0; ps[lane + 64] = p1; if (lane == 0) ps[128] = p2;
      float l = p0 + p1 + p2;
#pragma unroll
      for (int o = 32; o >= 1; o >>= 1) l += __shfl_xor(l, o);
      l += fexp(sink - mx);
      asm volatile("" ::: "memory");
      {
        const int g = lane >> 4, d4 = (lane & 15) * 4;
        f32x4 acc = (f32x4){0.f, 0.f, 0.f, 0.f};
#pragma unroll 8
        for (int it = 0; it < 32; ++it) {
          const int key = it * 4 + g;
          const f32x4 vv = *(const f32x4*)(cv + (size_t)key * 128 + kvh * 64 + d4);
          acc += vv * ps[key];
        }
        if (g == 0) { const f32x4 vn = *(const f32x4*)(ov + (size_t)127 * 128 + kvh * 64 + d4); acc += vn * ps[128]; }
#pragma unroll
        for (int j = 0; j < 4; ++j) { acc[j] += __shfl_xor(acc[j], 16); acc[j] += __shfl_xor(acc[j], 32); }
        if (g == 0) *(u32x2*)(cat + (size_t)(TP + sb) * 1024 + hq * 64 + d4) = pk4(acc * (1.f / l));
      }
      {
        f32x4 tk[8], tv[8];
#pragma unroll
        for (int it = 0; it < 8; ++it) {
          const int e = it * 512 + tid;
          if (e < 127 * 32) { tk[it] = *(const f32x4*)(ck + 128 + (size_t)e * 4); tv[it] = *(const f32x4*)(cv + 128 + (size_t)e * 4); }
        }
#pragma unroll
        for (int it = 0; it < 8; ++it) {
          const int e = it * 512 + tid;
          if (e < 127 * 32) { *(f32x4*)(ok + (size_t)e * 4) = tk[it]; *(f32x4*)(ov + (size_t)e * 4) = tv[it]; }
        }
      }
#endif
    } else {
#if !NOCONV
      const int cu = unit - NU_AP - NU_AS;
      int c = tid; asm volatile("" : "+v"(c));
      float* ys = (float*)shm;
      const float* cw = p.in[17] + (size_t)li * 31 * 512;
      float w[31];
#pragma unroll
      for (int j = 0; j < 31; ++j) w[j] = cw[j * 512 + c];
      const float bias = p.in[18][li * 512 + c];
      int tok0;
      int nvalid = 32; bool is_samp = false;
      if (cu < NU_CP) {
        const int b = cu / 129, tt = cu % 129, t0 = tt * 32;
        tok0 = b * SEQL + t0;
        nvalid = min(32, SEQL - t0);
        float zr[62];
#pragma unroll
        for (int j = 0; j < 62; ++j) {
          const int pos = t0 - 30 + j;
          zr[j] = (pos >= 0 && pos < SEQL) ? bf2f(zb[(size_t)(b * SEQL + pos) * 512 + c]) : 0.f;
        }
#pragma unroll
        for (int t = 0; t < 32; ++t) {
          float y = bias;
#pragma unroll
          for (int j = 0; j < 31; ++j) y += w[j] * zr[t + j];
          ys[t * 512 + c] = y;
        }
      } else {
        const int su = cu - NU_CP;
        tok0 = TP + su * 4;
        nvalid = 4; is_samp = true;
#pragma unroll
        for (int t = 0; t < 4; ++t) {
          const int sb = su * 4 + t;
          const float* st = p.in[2] + (size_t)(li * 128 + sb) * 30 * 512 + c;
          float* so = p.out + O_SCONV + (size_t)(li * 128 + sb) * 30 * 512 + c;
          float y = bias + w[0] * st[0];
#pragma unroll
          for (int j = 1; j < 30; ++j) { const float v = st[j * 512]; y += w[j] * v; so[(j - 1) * 512] = v; }
          y += w[30] * so[29 * 512];
          ys[t * 512 + c] = y;
        }
      }
      __syncthreads();
      int lane8 = lane * 8; asm volatile("" : "+v"(lane8));
      const float* lg = p.in[19] + li * 512 + lane8; const float* lb = p.in[20] + li * 512 + lane8;
      const f32x4 g0 = *(const f32x4*)lg, g1 = *(const f32x4*)(lg + 4), b0 = *(const f32x4*)lb, b1 = *(const f32x4*)(lb + 4);
#pragma unroll
      for (int q = 0; q < 4; ++q) {
        const int t = is_samp ? ((q == 0 && wave < 4) ? wave : 32) : (wave * 4 + q);
        if (t >= nvalid) continue;
        const f32x4 y0 = *(const f32x4*)(ys + t * 512 + lane * 8), y1 = *(const f32x4*)(ys + t * 512 + lane * 8 + 4);
        float s = y0[0] + y0[1] + y0[2] + y0[3] + y1[0] + y1[1] + y1[2] + y1[3];
#pragma unroll
        for (int o = 32; o >= 1; o >>= 1) s += __shfl_xor(s, o);
        const float mu = s * (1.f / 512.f);
        const f32x4 d0 = y0 - mu, d1 = y1 - mu;
        float vs = d0[0] * d0[0] + d0[1] * d0[1] + d0[2] * d0[2] + d0[3] * d0[3] + d1[0] * d1[0] + d1[1] * d1[1] + d1[2] * d1[2] + d1[3] * d1[3];
#pragma unroll
        for (int o = 32; o >= 1; o >>= 1) vs += __shfl_xor(vs, o);
        const float rs = rsqrtf(vs * (1.f / 512.f) + 1e-6f);
        f32x4 o0 = d0 * rs * g0 + b0, o1 = d1 * rs * g1 + b1;
#pragma unroll
        for (int j = 0; j < 4; ++j) { o0[j] = o0[j] * sigmoidf_(o0[j]); o1[j] = o1[j] * sigmoidf_(o1[j]); }
        if (t < nvalid) {
          u32x4 wv; const u32x2 a = pk4(o0), bq = pk4(o1); wv[0] = a[0]; wv[1] = a[1]; wv[2] = bq[0]; wv[3] = bq[1];
          *(u32x4*)(cat + (size_t)(tok0 + t) * 1024 + 512 + lane * 8) = wv;
        }
      }
#endif
    }
  }
}

struct SsmLane { float lr, li, bbr[16], bbi[16]; };

__device__ __forceinline__ void ssm_lane_params(const P& p, int li_, int g, int lane, SsmLane& o) {
  const float are = p.in[22][(li_ * 64 + g) * 64 + lane], aim = p.in[23][(li_ * 64 + g) * 64 + lane];
  const float dt = expf(p.in[24][li_ * 64 + g]);
  const float mag = expf(are * dt), ang = aim * dt;
  o.lr = mag * cosf(ang); o.li = mag * sinf(ang);
  const float den = are * are + aim * aim, nr = o.lr - 1.f;
  const float fre = (nr * are + o.li * aim) / den, fim = (o.li * are - nr * aim) / den;
  const float* br = p.in[25] + ((size_t)(li_ * 64 + g) * 64 + lane) * 16;
  const float* bi = p.in[26] + ((size_t)(li_ * 64 + g) * 64 + lane) * 16;
#pragma unroll
  for (int c4 = 0; c4 < 4; ++c4) {
    const f32x4 r4 = *(const f32x4*)(br + c4 * 4), i4 = *(const f32x4*)(bi + c4 * 4);
#pragma unroll
    for (int j = 0; j < 4; ++j) {
      o.bbr[c4 * 4 + j] = fre * r4[j] - fim * i4[j];
      o.bbi[c4 * 4 + j] = fre * i4[j] + fim * r4[j];
    }
  }
}

__device__ __forceinline__ void phase_ssm(const P& p, int li_, char* shm) {
  int tid = threadIdx.x; asm volatile("" : "+v"(tid));
  const int wave = tid >> 6, lane = tid & 63, fr = lane & 15, fq = lane >> 4;
  const bf16_t* uf = (const bf16_t*)(p.ws + B_UF);
  bf16_t* yb = (bf16_t*)(p.ws + B_CAT);
  const float* cre = p.in[27] + (size_t)li_ * 64 * 16 * 64; const float* cim = p.in[28] + (size_t)li_ * 64 * 16 * 64;
  const float* dsk = p.in[29] + li_ * 1024;
  float* u_s = (float*)(shm + wave * 13824);
  bf16_t* h_s = (bf16_t*)(shm + wave * 13824 + 1024);
  float* x_s = (float*)(shm + wave * 13824 + 1024 + 4352);
  float* xch = (float*)(shm + 8 * 13824);
  for (int unit = blockIdx.x; unit < 256; unit += gridDim.x) {
    const int b = unit >> 6, g = ((unit & 7) << 3) | ((unit >> 3) & 7);
    const float dt = expf(p.in[24][li_ * 64 + g]);
    float lr, li;
    { const float are = p.in[22][(li_ * 64 + g) * 64 + lane], aim = p.in[23][(li_ * 64 + g) * 64 + lane];
      const float mag = expf(are * dt), ang = aim * dt; lr = mag * cosf(ang); li = mag * sinf(ang); }
    float l16r = lr, l16i = li;
#pragma unroll
    for (int q = 0; q < 4; ++q) { const float nr_ = l16r * l16r - l16i * l16i, ni_ = 2.f * l16r * l16i; l16r = nr_; l16i = ni_; }
    bf16x8 bfrag[8];
#pragma unroll
    for (int q = 0; q < 4; ++q) {
      const int ps = 16 * q + fr;
      const float are = p.in[22][(li_ * 64 + g) * 64 + ps], aim = p.in[23][(li_ * 64 + g) * 64 + ps];
      const float mag = expf(are * dt), ang = aim * dt, l_r = mag * cosf(ang), l_i = mag * sinf(ang);
      const float den = are * are + aim * aim, nr = l_r - 1.f;
      const float fre = (nr * are + l_i * aim) / den, fim = (l_i * are - nr * aim) / den;
      u32x4 wr_ = (u32x4){0u, 0u, 0u, 0u}, wi_ = (u32x4){0u, 0u, 0u, 0u};
      if (fq < 2) {
        const float* br = p.in[25] + ((size_t)(li_ * 64 + g) * 64 + ps) * 16 + fq * 8;
        const float* bi = p.in[26] + ((size_t)(li_ * 64 + g) * 64 + ps) * 16 + fq * 8;
        const f32x4 r0 = *(const f32x4*)br, r1 = *(const f32x4*)(br + 4), i0 = *(const f32x4*)bi, i1 = *(const f32x4*)(bi + 4);
        const f32x4 re0 = r0 * fre - i0 * fim, re1 = r1 * fre - i1 * fim, im0 = i0 * fre + r0 * fim, im1 = i1 * fre + r1 * fim;
        wr_[0] = pk_bf16(re0[0], re0[1]); wr_[1] = pk_bf16(re0[2], re0[3]); wr_[2] = pk_bf16(re1[0], re1[1]); wr_[3] = pk_bf16(re1[2], re1[3]);
        wi_[0] = pk_bf16(im0[0], im0[1]); wi_[1] = pk_bf16(im0[2], im0[3]); wi_[2] = pk_bf16(im1[0], im1[1]); wi_[3] = pk_bf16(im1[2], im1[3]);
      }
      bfrag[q] = __builtin_bit_cast(bf16x8, wr_); bfrag[4 + q] = __builtin_bit_cast(bf16x8, wi_);
    }
    bf16x8 cfrag[4];
#pragma unroll
    for (int kk = 0; kk < 4; ++kk) {
      const int k = kk * 32 + fq * 8;
      const float* src = (k < 64) ? (cre + ((size_t)(g * 16 + fr)) * 64 + k) : (cim + ((size_t)(g * 16 + fr)) * 64 + (k - 64));
      const float sg = (k < 64) ? 1.f : -1.f;
      const f32x4 a = *(const f32x4*)src * sg, c2 = *(const f32x4*)(src + 4) * sg;
      u32x4 w; w[0] = pk_bf16(a[0], a[1]); w[1] = pk_bf16(a[2], a[3]); w[2] = pk_bf16(c2[0], c2[1]); w[3] = pk_bf16(c2[2], c2[3]);
      cfrag[kk] = __builtin_bit_cast(bf16x8, w);
    }
    const f32x4 dsk4 = *(const f32x4*)(dsk + g * 16 + fq * 4);
    const int t0 = wave * 512, nsub = (wave == 7) ? 33 : 32;
    const bf16_t* ubase = uf + ((size_t)(b * SEQL + t0)) * DM + g * 16;
    float hr = 0.f, hi = 0.f, pr = 1.f, pi = 0.f;
#pragma unroll 1
    for (int pass = 0; pass < 2; ++pass) {
      u32x2 unext = *(const u32x2*)(ubase + (size_t)(lane >> 2) * DM + (lane & 3) * 4);
      for (int sbk = 0; sbk < nsub; ++sbk) {
        { f32x4 v; v[0] = bfw_lo(unext[0]); v[1] = bfw_hi(unext[0]); v[2] = bfw_lo(unext[1]); v[3] = bfw_hi(unext[1]);
          if (sbk + 1 < nsub) unext = *(const u32x2*)(ubase + (size_t)((sbk + 1) * 16 + (lane >> 2)) * DM + (lane & 3) * 4);
          asm volatile("" ::: "memory");
          *(f32x4*)(u_s + (lane >> 2) * 16 + (lane & 3) * 4) = v; }
        asm volatile("" ::: "memory");
        {
          u32x4 uw = (u32x4){0u, 0u, 0u, 0u};
          if (fq < 2) {
            const f32x4 a = *(const f32x4*)(u_s + fr * 16 + fq * 8), c2 = *(const f32x4*)(u_s + fr * 16 + fq * 8 + 4);
            uw[0] = pk_bf16(a[0], a[1]); uw[1] = pk_bf16(a[2], a[3]); uw[2] = pk_bf16(c2[0], c2[1]); uw[3] = pk_bf16(c2[2], c2[3]);
          }
          const bf16x8 ufrag = __builtin_bit_cast(bf16x8, uw);
#pragma unroll
          for (int nt = 0; nt < 8; ++nt) {
            const f32x4 d = __builtin_amdgcn_mfma_f32_16x16x32_bf16(bfrag[nt], ufrag, (f32x4){0.f, 0.f, 0.f, 0.f}, 0, 0, 0);
            *(f32x4*)(x_s + fr * 132 + 16 * nt + 4 * fq) = d;
          }
        }
        asm volatile("" ::: "memory");
        if (pass == 0) {
#pragma unroll
          for (int t = 0; t < 16; ++t) {
            const float xr = x_s[t * 132 + lane], xi = x_s[t * 132 + 64 + lane];
            const float nh = lr * hr - li * hi + xr, ni = lr * hi + li * hr + xi;
            hr = nh; hi = ni;
          }
          { const float npr = pr * l16r - pi * l16i, npi = pr * l16i + pi * l16r; pr = npr; pi = npi; }
        } else {
#pragma unroll
          for (int t = 0; t < 16; ++t) {
            const float xr = x_s[t * 132 + lane], xi = x_s[t * 132 + 64 + lane];
            const float nh = lr * hr - li * hi + xr, ni = lr * hi + li * hr + xi;
            hr = nh; hi = ni;
            const unsigned pk = pk_bf16(hr, hi);
            h_s[t * 136 + lane] = (bf16_t)(pk & 0xffff);
            h_s[t * 136 + 64 + lane] = (bf16_t)(pk >> 16);
          }
          asm volatile("" ::: "memory");
          f32x4 acc = (f32x4){0.f, 0.f, 0.f, 0.f};
#pragma unroll
          for (int kk = 0; kk < 4; ++kk) {
            const bf16x8 a = *(const bf16x8*)(h_s + fr * 136 + kk * 32 + fq * 8);
            acc = __builtin_amdgcn_mfma_f32_16x16x32_bf16(cfrag[kk], a, acc, 0, 0, 0);
          }
          {
            const f32x4 uv = *(const f32x4*)(u_s + fr * 16 + fq * 4);
            f32x4 y;
#pragma unroll
            for (int j = 0; j < 4; ++j) y[j] = gelu_tanh(acc[j] + dsk4[j] * uv[j]);
            *(u32x2*)(yb + ((size_t)(b * SEQL + t0 + sbk * 16 + fr)) * DM + g * 16 + fq * 4) = pk4(y);
          }
        }
        asm volatile("" ::: "memory");
      }
      if (pass == 0) {
        *(f32x4*)(xch + (wave * 64 + lane) * 4) = (f32x4){hr, hi, pr, pi};
        __syncthreads();
        hr = 0.f; hi = 0.f;
        for (int w2 = 0; w2 < wave; ++w2) {
          const f32x4 e = *(const f32x4*)(xch + (w2 * 64 + lane) * 4);
          const float nh = e[2] * hr - e[3] * hi + e[0], ni = e[2] * hi + e[3] * hr + e[1];
          hr = nh; hi = ni;
        }
      }
    }
    if (wave == 7) {
      p.out[O_PRE + ((size_t)(li_ * 4 + b) * 64 + g) * 64 + lane] = hr;
      p.out[O_PIM + ((size_t)(li_ * 4 + b) * 64 + g) * 64 + lane] = hi;
    }
    __syncthreads();
  }
  const bool same_g = ((gridDim.x * 8) & 63) == 0;
  SsmLane sp;
  if (same_g) ssm_lane_params(p, li_, (blockIdx.x * 8 + wave) & 63, lane, sp);
  for (int item = blockIdx.x * 8 + wave; item < 128 * 64; item += gridDim.x * 8) {
    const int sb = item >> 6, g = item & 63;
    if (!same_g) ssm_lane_params(p, li_, g, lane, sp);
    const bf16_t* up = uf + (size_t)(TP + sb) * DM + g * 16;
    float uu[16];
#pragma unroll
    for (int c4 = 0; c4 < 4; ++c4) { const u32x2 w_ = *(const u32x2*)(up + c4 * 4); f32x4 v; v[0] = bfw_lo(w_[0]); v[1] = bfw_hi(w_[0]); v[2] = bfw_lo(w_[1]); v[3] = bfw_hi(w_[1]); uu[c4 * 4] = v[0]; uu[c4 * 4 + 1] = v[1]; uu[c4 * 4 + 2] = v[2]; uu[c4 * 4 + 3] = v[3]; }
    float xr = 0.f, xi = 0.f;
#pragma unroll
    for (int c = 0; c < 16; ++c) { xr += sp.bbr[c] * uu[c]; xi += sp.bbi[c] * uu[c]; }
    const size_t sidx = ((size_t)(li_ * 128 + sb) * 64 + g) * 64 + lane;
    const float sr = p.in[5][sidx], si = p.in[6][sidx];
    const float hr = sp.lr * sr - sp.li * si + xr, hi = sp.lr * si + sp.li * sr + xi;
    p.out[O_SRE + sidx] = hr; p.out[O_SIM + sidx] = hi;
    float ymine = 0.f;
#pragma unroll
    for (int c = 0; c < 16; ++c) {
      float v = cre[((size_t)(g * 16 + c)) * 64 + lane] * hr - cim[((size_t)(g * 16 + c)) * 64 + lane] * hi;
#pragma unroll
      for (int o = 32; o >= 1; o >>= 1) v += __shfl_xor(v, o);
      ymine = (lane == c) ? v : ymine;
    }
    if (lane < 16) {
      float un = uu[0];
#pragma unroll
      for (int c = 1; c < 16; ++c) un = (lane == c) ? uu[c] : un;
      const float y = ymine + dsk[g * 16 + lane] * un;
      yb[(size_t)(TP + sb) * DM + g * 16 + lane] = (bf16_t)(pk_bf16(gelu_tanh(y), 0.f) & 0xffff);
    }
  }
}


#define XB_TMO      128
#define XB_XCNT(j)  (256  + 64 * (j))
#define XB_XSUB(j)  (1280 + 64 * (j))
#define XB_XGEN(j)  (2304 + 64 * (j))
#define XB_TOP      3328
#define XB_TOPGEN   3392
#define XCD_BAR_WORDS 3456
#define XB_SPIN_CAP (1u << 18)
__device__ __forceinline__ unsigned xb_ld(unsigned* p)              { return __hip_atomic_load(p, __ATOMIC_RELAXED, __HIP_MEMORY_SCOPE_AGENT); }
__device__ __forceinline__ unsigned xb_add(unsigned* p, unsigned v) { return __hip_atomic_fetch_add(p, v, __ATOMIC_RELAXED, __HIP_MEMORY_SCOPE_AGENT); }
__device__ __forceinline__ unsigned xb_xcc_id() { return (unsigned)__builtin_amdgcn_s_getreg((3 << 11) | 20) & 0xFu; }
#define XB_SPIN(cond, bar) do { unsigned _sp = 0; while (cond) { __builtin_amdgcn_s_sleep(1); \
    if ((++_sp & 255u) == 0u) { if (xb_ld(&(bar)[XB_TMO])) break; if (_sp > XB_SPIN_CAP) { atomicAdd(&(bar)[XB_TMO], 1u); break; } } } } while (0)
struct XcdBarrier { unsigned* bar; unsigned x; volatile LAS unsigned* st; };
__device__ __forceinline__ XcdBarrier xcd_barrier_post(unsigned* bar, volatile LAS unsigned* st) {
  XcdBarrier b; b.bar = bar; b.x = xb_xcc_id(); b.st = st;
  if (threadIdx.x == 0) (void)xb_add(&bar[XB_XCNT(b.x)], 1u);
  return b;
}
__device__ __forceinline__ void xcd_barrier_complete(unsigned* bar, unsigned x, unsigned& nloc, unsigned& nx) {
  const unsigned G = gridDim.x * gridDim.y * gridDim.z;
  unsigned sum, cnt, mine, sp = 0u;
  for (;;) {
    sum = 0u; cnt = 0u; mine = 0u;
#pragma unroll
    for (unsigned j = 0; j < 16; ++j) { const unsigned c = xb_ld(&bar[XB_XCNT(j)]); sum += c; cnt += (c > 0u) ? 1u : 0u; mine = (j == x) ? c : mine; }
    if (sum == G) break;
    __builtin_amdgcn_s_sleep(1);
    if ((++sp & 255u) == 0u) { if (xb_ld(&bar[XB_TMO])) break; if (sp > XB_SPIN_CAP) { atomicAdd(&bar[XB_TMO], 1u); break; } }
  }
  nloc = mine > 0u ? mine : 1u; nx = cnt > 0u ? cnt : 1u;
}
__device__ __forceinline__ void xcd_barrier(const XcdBarrier& b) {
  asm volatile("s_waitcnt vmcnt(0)" ::: "memory");
  __syncthreads();
  if (threadIdx.x == 0) {
    unsigned* bar = b.bar;
    __builtin_amdgcn_s_waitcnt(0);
    unsigned nloc = b.st[0], nx = b.st[1];
    if (nloc == 0u) { xcd_barrier_complete(bar, b.x, nloc, nx); b.st[0] = nloc; b.st[1] = nx; }
    const unsigned old = xb_add(&bar[XB_XSUB(b.x)], 1u);
    const unsigned gen = old / nloc;
    if (old + 1u == (gen + 1u) * nloc) {
      __builtin_amdgcn_fence(__ATOMIC_RELEASE, "agent");
      asm volatile("s_waitcnt vmcnt(0)" ::: "memory");
      const unsigned og = xb_add(&bar[XB_TOP], 1u);
      const unsigned tg = og / nx;
      if (og + 1u == (tg + 1u) * nx) xb_add(&bar[XB_TOPGEN], 1u);
      else XB_SPIN(xb_ld(&bar[XB_TOPGEN]) == tg, bar);
      __builtin_amdgcn_fence(__ATOMIC_ACQUIRE, "agent");
      xb_add(&bar[XB_XGEN(b.x)], 1u);
      asm volatile("s_waitcnt vmcnt(0)" ::: "memory");
    } else {
      XB_SPIN(xb_ld(&bar[XB_XGEN(b.x)]) == gen, bar);
      __builtin_amdgcn_fence(__ATOMIC_ACQUIRE, "agent");
      asm volatile("s_waitcnt vmcnt(0)" ::: "memory");
    }
  }
  __syncthreads();
}

template <int PH>
__device__ __forceinline__ void run_phase(LAS char* lds, char* shm_raw) {
  unsigned long long kp_ = (unsigned long long)__builtin_amdgcn_kernarg_segment_ptr();
  asm volatile("" : "+s"(kp_));
  const __attribute__((address_space(4))) unsigned long long* ka_ = (const __attribute__((address_space(4))) unsigned long long*)kp_;
  P p;
#pragma unroll
  for (int q = 0; q < 31; ++q) p.in[q] = (const float*)(const __attribute__((address_space(1))) float*)ka_[q];
  p.out = (float*)(__attribute__((address_space(1))) float*)ka_[31]; p.ws = (char*)(__attribute__((address_space(1))) char*)ka_[32];
  char* ws = p.ws;
  bf16_t* x = (bf16_t*)(ws + B_X); bf16_t* xb = (bf16_t*)(ws + B_XB); float* ssq = (float*)(ws + B_SSQ);
  bf16_t* hid = (bf16_t*)(ws + B_HID); bf16_t* cat = (bf16_t*)(ws + B_CAT);
  if constexpr (PH == 0) {
    phase_init(p, (float*)shm_raw);
  } else if constexpr (PH == NPHASE - 1) {
    phase_final(p);
  } else {
    constexpr int l = (PH - 1) / 7, k = (PH - 1) % 7, i = l >> 1;
    constexpr bool even = (l & 1) == 0;
    if constexpr (k == 0 || k == 5) {
      EpiSwiglu e; e.hid = hid; e.ssq = ssq;
      gemm_phase(xb, (const bf16_t*)(ws + W_GU + (size_t)(l * 2 + (k == 5)) * SZ_GU), 5632, 1024, e, lds, TPAD / G8_BM, ssq);
    } else if constexpr (k == 1 || k == 6) {
      EpiResid e; e.xl = x; e.xb = xb; e.ssq = ssq; e.alpha = 0.5f;
      const bf16_t* wd_ = (const bf16_t*)(ws + W_DOWN + (size_t)(l * 2 + (k == 6)) * SZ_DOWN);
      MiniResid me; me.xl = x; me.xb = xb; me.ssq = ssq; me.alpha = 0.5f;
      mini_phase(hid, wd_, 2816, me, shm_raw);
      gemm_phase(hid, wd_, 1024, 2816, e, lds, 64);
    } else if constexpr (k == 2) {
      if constexpr (even) {
        EpiAbIn e; e.qb = (bf16_t*)(ws + B_QB); e.kb = (bf16_t*)(ws + B_KB); e.vb = (bf16_t*)(ws + B_VB); e.zb = (bf16_t*)(ws + B_ZB);
        e.rope = (const float*)(ws + B_ROPE); e.out = p.out; e.li = i; e.ssq = ssq;
        gemm_phase(xb, (const bf16_t*)(ws + W_ABIN + (size_t)i * SZ_ABIN), 1792, 1024, e, lds, TPAD / G8_BM, ssq);
      } else {
        EpiSsmIn e; e.uf = (bf16_t*)(ws + B_UF); e.ssq = ssq;
        MiniSsmIn me; me.uf = (bf16_t*)(ws + B_UF); me.ssq = ssq;
        mini_phase(xb, (const bf16_t*)(ws + W_SSMIN + (size_t)i * SZ_SQ), 1024, me, shm_raw);
        gemm_phase(xb, (const bf16_t*)(ws + W_SSMIN + (size_t)i * SZ_SQ), 1024, 1024, e, lds, 64, ssq);
      }
    } else if constexpr (k == 3) {
      if constexpr (even) phase_mix_ab(p, i, shm_raw); else phase_ssm(p, i, shm_raw);
    } else {
      if constexpr (even) {
        EpiResid e; e.xl = x; e.xb = xb; e.ssq = ssq; e.alpha = 1.0f;
        MiniResid me; me.xl = x; me.xb = xb; me.ssq = ssq; me.alpha = 1.0f;
        mini_phase(cat, (const bf16_t*)(ws + W_ABOUT + (size_t)i * SZ_SQ), 1024, me, shm_raw);
        gemm_phase(cat, (const bf16_t*)(ws + W_ABOUT + (size_t)i * SZ_SQ), 1024, 1024, e, lds, 64);
      } else {
        EpiResidGlu e; e.xl = x; e.xb = xb; e.ssq = ssq;
        mini_glu_phase(cat, (const bf16_t*)(ws + W_GLU + (size_t)i * SZ_GLU), x, xb, ssq, shm_raw);
        gemm_phase(cat, (const bf16_t*)(ws + W_GLU + (size_t)i * SZ_GLU), 2048, 1024, e, lds, 64);
      }
    }
  }
}

template <int PH>
__device__ __forceinline__ void run_from(LAS char* lds, char* shm_raw, int lo, int hi, const XcdBarrier& xb) {
  if constexpr (PH < NPHASE) {
    if (PH >= lo && PH < hi) {
      run_phase<PH>(lds, shm_raw);
      constexpr int kk_ = (PH >= 1 && PH < NPHASE - 1) ? (PH - 1) % 7 : -1;
      constexpr bool odd_ = (PH >= 1 && PH < NPHASE - 1) ? ((((PH - 1) / 7) & 1) == 1) : false;
      constexpr bool rep_ = (PROBE_GU && (kk_ == 0 || kk_ == 5)) || (PROBE_INIT && PH == 0) || (PROBE_SSM && kk_ == 3 && odd_) || (PROBE_MIX && kk_ == 3 && !odd_ && PH > 0);
      if constexpr (rep_) { xcd_barrier(xb); run_phase<PH>(lds, shm_raw); }
      if (PH + 1 < hi) { if constexpr (PH == 0) cg::this_grid().sync(); else xcd_barrier(xb); }
    }
    run_from<PH + 1>(lds, shm_raw, lo, hi, xb);
  }
}

__global__ __launch_bounds__(512, 2) void mega(P p_arg, int lo, int hi) {
  __shared__ __attribute__((aligned(1024))) char shm_raw[131072 + 2048];
  LAS char* lds = (LAS char*)shm_raw;
  __shared__ uint4 xb_words;
  if (threadIdx.x == 0) xb_words = make_uint4(0u, 0u, 0u, 0u);
  __syncthreads();
  const XcdBarrier xb = xcd_barrier_post((unsigned*)(p_arg.ws + B_BAR), (volatile LAS unsigned*)&xb_words);
  run_from<0>(lds, shm_raw, lo, hi, xb);
}

extern "C" void kernel_launch(void* const* d_in, const int* in_sizes, int n_in, void* d_out, int out_size, void* d_ws,
                              size_t ws_size, hipStream_t stream) {
  static int grid_blocks = 0;
  if (!grid_blocks) {
    int dev = 0, cus = 0, per_cu = 0;
    hipGetDevice(&dev);
    hipDeviceGetAttribute(&cus, hipDeviceAttributeMultiprocessorCount, dev);
    hipOccupancyMaxActiveBlocksPerMultiprocessor(&per_cu, mega, 512, 0);
    if (per_cu < 1) per_cu = 1;
    grid_blocks = cus;
    if (ws_size < WS_NEED) fprintf(stderr, "workspace too small: %zu < %zu\n", ws_size, (size_t)WS_NEED);
  }
  P p{};
  for (int i = 0; i < 31; ++i) p.in[i] = (const float*)d_in[i];
  p.out = (float*)d_out;
  p.ws = (char*)d_ws;
#if MULTI_LAUNCH
  for (int ph = 0; ph < NPHASE; ++ph) {
    int lo = ph, hi = ph + 1;
    hipLaunchKernelGGL(mega, dim3(grid_blocks), dim3(512), 0, stream, p, lo, hi);
  }
#else
  hipMemsetAsync((char*)d_ws + B_BAR, 0, 16384, stream);
  int lo = 0, hi = NPHASE;
  void* args[] = {&p, &lo, &hi};
  hipError_t e = hipLaunchCooperativeKernel((void*)mega, dim3(grid_blocks), dim3(512), args, 0, stream);
  if (e != hipSuccess) fprintf(stderr, "cooperative launch failed: %s (grid %d)\n", hipGetErrorString(e), grid_blocks);
#endif
}
```

```cpp
#include <hip/hip_runtime.h>
#include <hip/hip_cooperative_groups.h>
#include <cstdio>
namespace cg = cooperative_groups;

#ifndef ONLYG
#define ONLYG 0
#endif
#ifndef NOINIT
#define NOINIT 0
#endif
#ifndef NOMIX
#define NOMIX 0
#endif
#ifndef NOSSM
#define NOSSM 0
#endif
#ifndef NOATTN
#define NOATTN 0
#endif
#ifndef NOATTS
#define NOATTS 0
#endif
#ifndef NOCONV
#define NOCONV 0
#endif
#ifndef PROBE_GU
#define PROBE_GU 0
#endif
#ifndef PROBE_INIT
#define PROBE_INIT 0
#endif
#ifndef PROBE_SSM
#define PROBE_SSM 0
#endif
#ifndef PROBE_MIX
#define PROBE_MIX 0
#endif
#ifndef XLO
#define XLO 0
#endif
#ifndef MULTI_LAUNCH
#define MULTI_LAUNCH 0
#endif

#define LAS __attribute__((address_space(3)))
typedef unsigned short bf16_t;
typedef short bf16x8 __attribute__((ext_vector_type(8)));
typedef float f32x4 __attribute__((ext_vector_type(4)));
typedef unsigned u32x2 __attribute__((ext_vector_type(2)));
typedef float f32x2_t __attribute__((ext_vector_type(2)));
typedef unsigned u32x4 __attribute__((ext_vector_type(4)));

constexpr int DM = 1024, SEQL = 4112, NBATCH = 4, TP = NBATCH * SEQL, TS = 128, TT = TP + TS, TPAD = 16640;
constexpr int DFF = 2816;
constexpr int NPHASE = 30;

constexpr size_t O_YP = 0;
constexpr size_t O_YS = O_YP + (size_t)4 * 4096 * 1024;
constexpr size_t O_PCONV = O_YS + 131072;
constexpr size_t O_PK = O_PCONV + 122880;
constexpr size_t O_PV = O_PK + 131072;
constexpr size_t O_PRE = O_PV + 131072;
constexpr size_t O_PIM = O_PRE + 32768;
constexpr size_t O_SCONV = O_PIM + 32768;
constexpr size_t O_SK = O_SCONV + 3932160;
constexpr size_t O_SV = O_SK + 4194304;
constexpr size_t O_SRE = O_SV + 4194304;
constexpr size_t O_SIM = O_SRE + 1048576;

constexpr size_t SZ_GU = (size_t)5632 * 1024 * 2, SZ_DOWN = (size_t)1024 * 2816 * 2, SZ_ABIN = (size_t)1792 * 1024 * 2;
constexpr size_t SZ_SQ = (size_t)1024 * 1024 * 2, SZ_GLU = (size_t)2048 * 1024 * 2;
constexpr size_t W_GU = 0;
constexpr size_t W_DOWN = W_GU + 8 * SZ_GU;
constexpr size_t W_ABIN = W_DOWN + 8 * SZ_DOWN;
constexpr size_t W_ABOUT = W_ABIN + 2 * SZ_ABIN;
constexpr size_t W_SSMIN = W_ABOUT + 2 * SZ_SQ;
constexpr size_t W_GLU = W_SSMIN + 2 * SZ_SQ;
constexpr size_t B_X = W_GLU + 2 * SZ_GLU;
constexpr size_t B_XB = B_X + (size_t)TPAD * 1024 * 4;
constexpr size_t B_SSQ = B_XB + (size_t)TPAD * 1024 * 2;
constexpr size_t B_ROPE = B_SSQ + (size_t)TPAD * 32 * 4;
constexpr size_t B_CAT = B_ROPE + 263424;
constexpr size_t B_HID = B_CAT + (size_t)TPAD * 1024 * 2;
constexpr size_t B_QB = B_HID;
constexpr size_t B_KB = B_QB + (size_t)TPAD * 512 * 2;
constexpr size_t B_VB = B_KB + (size_t)TPAD * 128 * 2;
constexpr size_t B_ZB = B_VB + (size_t)TPAD * 128 * 2;
constexpr size_t B_UF = B_HID;
constexpr size_t B_BAR = B_HID + (size_t)TPAD * 2816 * 2;
constexpr size_t WS_NEED = B_BAR + 16384;

struct P {
  const float* in[31];
  float* out;
  char* ws;
};

__device__ __forceinline__ unsigned pk_bf16(float lo, float hi) {
  unsigned r;
  asm("v_cvt_pk_bf16_f32 %0, %1, %2" : "=v"(r) : "v"(lo), "v"(hi));
  return r;
}
__device__ __forceinline__ float bf2f(unsigned short h) { return __uint_as_float(((unsigned)h) << 16); }
__device__ __forceinline__ u32x2 pk4(f32x4 v) { u32x2 r; r[0] = pk_bf16(v[0], v[1]); r[1] = pk_bf16(v[2], v[3]); return r; }
__device__ __forceinline__ float bfw_lo(unsigned w) { return __uint_as_float(w << 16); }
__device__ __forceinline__ float bfw_hi(unsigned w) { return __uint_as_float(w & 0xffff0000u); }
__device__ __forceinline__ f32x4 hl_join4(u32x2 h, u32x2 l) {
  f32x4 r; r[0] = bfw_lo(h[0]) + bfw_lo(l[0]); r[1] = bfw_hi(h[0]) + bfw_hi(l[0]); r[2] = bfw_lo(h[1]) + bfw_lo(l[1]); r[3] = bfw_hi(h[1]) + bfw_hi(l[1]); return r;
}
__device__ __forceinline__ void hl_split4(f32x4 v, u32x2& h, u32x2& l) {
  h = pk4(v);
  f32x4 hf; hf[0] = bfw_lo(h[0]); hf[1] = bfw_hi(h[0]); hf[2] = bfw_lo(h[1]); hf[3] = bfw_hi(h[1]);
  l = pk4(v - hf);
}
__device__ __forceinline__ float fexp(float x) { return __builtin_amdgcn_exp2f(x * 1.4426950408889634f); }
__device__ __forceinline__ float sigmoidf_(float x) { return __builtin_amdgcn_rcpf(1.f + __builtin_amdgcn_exp2f(x * -1.4426950408889634f)); }
__device__ __forceinline__ float gelu_tanh(float y) {
  const float t = 0.7978845608028654f * (y + 0.044715f * y * y * y);
  const float e = __builtin_amdgcn_exp2f(t * 2.8853900817779268f);
  const float th = 1.f - 2.f * __builtin_amdgcn_rcpf(e + 1.f);
  return 0.5f * y * (1.f + th);
}

__device__ __forceinline__ int lds_byte2(int r, int c) {
  int st = (r >> 4) * 2 + (c >> 5), ob = (r & 15) * 64 + (c & 31) * 2;
  return st * 1024 + (ob ^ (((ob >> 9) & 1) << 5));
}
__device__ __forceinline__ void stage_rc2(int b, int& R, int& C) {
  int st = b >> 10, sb = b & 1023, swz = sb ^ (((sb >> 9) & 1) << 5);
  R = (st / 2) * 16 + swz / 64;
  C = (st % 2) * 32 + (swz % 64) / 2;
}
#define WAIT_V(n) asm volatile("s_waitcnt vmcnt(%0)" ::"n"(n) : "memory")

struct Unit { int pm, pn; };
constexpr int G8_BM = 256, G8_BK = 64, G8_HALF = 128, G8_HTB = G8_HALF * G8_BK * 2;

__device__ __forceinline__ bool unit_next(int i, int nN, int nM, Unit& u) {
  const int nwg = nM * nN;
  const long L = (long)i * gridDim.x + blockIdx.x;
  if (L >= nwg) return false;
  int wgid = (int)L;
  { const int q = nwg / 8, r = nwg % 8, xcd = wgid % 8, off = wgid / 8; wgid = (xcd < r ? xcd * (q + 1) : r * (q + 1) + (xcd - r) * q) + off; }
  const int nig = 8 * nN, gid = wgid / nig, fm = gid * 8, gsz = (nM - fm) < 8 ? (nM - fm) : 8;
  u.pm = fm + ((wgid % nig) % gsz); u.pn = (wgid % nig) / gsz;
  return true;
}

__device__ __forceinline__ void load_rstd(const float* __restrict__ ssq, int pm, int wr, int lane, int fr, float (&rs)[2][4]) {
  const f32x4* sp0 = (const f32x4*)(ssq + (size_t)(pm * 256 + wr * 64 + lane) * 32);
  const f32x4* sp1 = sp0 + 128 * 8;
  f32x4 a = sp0[0], b = sp1[0];
#pragma unroll
  for (int i = 1; i < 8; ++i) { a += sp0[i]; b += sp1[i]; }
  const float r0 = rsqrtf((a[0] + a[1] + a[2] + a[3]) * (1.f / 1024.f) + 1e-6f);
  const float r1 = rsqrtf((b[0] + b[1] + b[2] + b[3]) * (1.f / 1024.f) + 1e-6f);
#pragma unroll
  for (int m = 0; m < 4; ++m) { rs[0][m] = __shfl(r0, m * 16 + fr); rs[1][m] = __shfl(r1, m * 16 + fr); }
}

template <class Epi>
__device__ __forceinline__ void gemm_phase(const bf16_t* __restrict__ Ag, const bf16_t* __restrict__ Btg, int N, int K, const Epi& E, LAS char* lds, int nM = TPAD / G8_BM, const float* __restrict__ ssq_in = nullptr) {
  LAS float* rstd_s = (LAS float*)(lds + 131072);
  int tid = threadIdx.x; asm volatile("" : "+v"(tid));
  const int wid = __builtin_amdgcn_readfirstlane(tid >> 6), lane = tid & 63, wr = wid >> 2, wc = wid & 3, fr = lane & 15, fq = lane >> 4;
  const int nN = N / G8_BM, nt = K / G8_BK;
  unsigned voff[2];
#pragma unroll
  for (int i = 0; i < 2; ++i) { int R, C; stage_rc2(tid * 16 + i * 8192, R, C); voff[i] = (unsigned)(R * K + C) * 2u; }
  const size_t kstep = (size_t)(G8_BK * 2);
  const size_t hstep = (size_t)G8_HALF * K * 2;
  const size_t tstep = 2 * hstep;
  const unsigned ldsw = (unsigned)wid * 1024u;
  const int aoff = lds_byte2(wr * 64 + fr, fq * 8), boff = lds_byte2(wc * 32 + fr, fq * 8);
#define G8_SA(b, h) (((b) * 2 + (h)) * G8_HTB)
#define G8_SB(b, h) ((4 + (b) * 2 + (h)) * G8_HTB)
#define G8_STAGE(bufoff, gbase) do { _Pragma("unroll") for (int _i = 0; _i < 2; ++_i) \
    __builtin_amdgcn_global_load_lds((const unsigned*)((const char*)(gbase) + voff[_i]), (LAS unsigned*)(lds + (bufoff) + ldsw + _i * 8192), 16, 0, 0); } while (0)
#define G8_LDA(dst, b, h) do { _Pragma("unroll") for (int m = 0; m < 4; ++m) _Pragma("unroll") for (int k = 0; k < 2; ++k) dst[m][k] = *(const LAS bf16x8*)(lds + G8_SA(b, h) + aoff + m * 2048 + k * 1024); } while (0)
#define G8_LDB(dst, b, h) do { _Pragma("unroll") for (int n = 0; n < 2; ++n) _Pragma("unroll") for (int k = 0; k < 2; ++k) dst[n][k] = *(const LAS bf16x8*)(lds + G8_SB(b, h) + boff + n * 2048 + k * 1024); } while (0)
#define G8_MMA(ai, bj, At, Bt) do { __builtin_amdgcn_s_setprio(1); _Pragma("unroll") for (int m = 0; m < 4; ++m) _Pragma("unroll") for (int n = 0; n < 2; ++n) _Pragma("unroll") for (int k = 0; k < 2; ++k) \
    acc[ai][bj][m][n] = __builtin_amdgcn_mfma_f32_16x16x32_bf16(Bt[n][k], At[m][k], acc[ai][bj][m][n], 0, 0, 0); __builtin_amdgcn_s_setprio(0); } while (0)
#define G8_WAIT_V(n) asm volatile("s_waitcnt vmcnt(" #n ")" ::: "memory")
#define G8_WAIT_L(n) asm volatile("s_waitcnt lgkmcnt(" #n ")" ::: "memory")
#define G8_BAR __builtin_amdgcn_s_barrier()
#define G8_SCHED __builtin_amdgcn_sched_barrier(0)
  Unit cur, nxt; int ui = 0;
  if (!unit_next(0, nN, nM, cur)) return;
  f32x4 acc[2][2][4][2];
#pragma unroll
  for (int a = 0; a < 2; ++a)
#pragma unroll
    for (int b = 0; b < 2; ++b)
#pragma unroll
      for (int m = 0; m < 4; ++m)
#pragma unroll
        for (int n = 0; n < 2; ++n) acc[a][b][m][n] = (f32x4){0.f, 0.f, 0.f, 0.f};
  bf16x8 At[4][2], B0[2][2], B1[2][2];
  const char* cA = (const char*)Ag + (size_t)cur.pm * tstep; const char* cB = (const char*)Btg + (size_t)cur.pn * tstep;
  if (Epi::NEED_RSTD && tid < 256) {
    const f32x4* sp = (const f32x4*)(ssq_in + (size_t)(cur.pm * 256 + tid) * 32);
    f32x4 a = sp[0];
#pragma unroll
    for (int i = 1; i < 8; ++i) a += sp[i];
    rstd_s[tid] = rsqrtf((a[0] + a[1] + a[2] + a[3]) * (1.f / 1024.f) + 1e-6f);
  }
  __syncthreads();
  G8_STAGE(G8_SB(0, 0), cB); G8_STAGE(G8_SA(0, 0), cA); G8_STAGE(G8_SB(0, 1), cB + hstep); G8_STAGE(G8_SA(0, 1), cA + hstep);
  if (wr == 1) G8_BAR;
  G8_WAIT_V(4); G8_BAR;
  G8_STAGE(G8_SB(1, 0), cB + kstep); G8_STAGE(G8_SA(1, 0), cA + kstep); G8_STAGE(G8_SB(1, 1), cB + hstep + kstep);
  G8_WAIT_V(6); G8_BAR;
  for (;;) {
    const bool has_next = unit_next(ui + 1, nN, nM, nxt);
    const char* nA = has_next ? (const char*)Ag + (size_t)nxt.pm * tstep : cA; const char* nB = has_next ? (const char*)Btg + (size_t)nxt.pn * tstep : cB;
    for (int t = 0; t < nt; t += 2) {
      const bool last = (t == nt - 2);
      const char* a1 = cA + (size_t)(t + 1) * kstep;
      const char* a2 = last ? nA : cA + (size_t)(t + 2) * kstep; const char* b2 = last ? nB : cB + (size_t)(t + 2) * kstep;
      const char* a3 = a2 + kstep; const char* b3 = b2 + kstep;
      G8_LDB(B0, 0, 0); G8_SCHED; G8_LDA(At, 0, 0); G8_STAGE(G8_SA(1, 1), a1 + hstep);
      G8_WAIT_L(8); G8_BAR; G8_WAIT_L(0); G8_MMA(0, 0, At, B0); G8_BAR; G8_SCHED;
      G8_LDB(B1, 0, 1); G8_STAGE(G8_SB(0, 0), b2);
      G8_BAR; G8_WAIT_L(0); G8_MMA(0, 1, At, B1); G8_BAR;
      G8_LDA(At, 0, 1); G8_STAGE(G8_SA(0, 0), a2);
      G8_BAR; G8_WAIT_L(0); G8_MMA(1, 0, At, B0); G8_BAR; G8_SCHED;
      G8_STAGE(G8_SB(0, 1), b2 + hstep);
      G8_WAIT_V(6); G8_BAR; G8_MMA(1, 1, At, B1); G8_BAR;
      G8_LDB(B0, 1, 0); G8_SCHED; G8_LDA(At, 1, 0); G8_STAGE(G8_SA(0, 1), a2 + hstep);
      G8_WAIT_L(8); G8_BAR; G8_WAIT_L(0); G8_MMA(0, 0, At, B0); G8_BAR; G8_SCHED;
      G8_LDB(B1, 1, 1); G8_STAGE(G8_SB(1, 0), b3);
      G8_BAR; G8_WAIT_L(0); G8_MMA(0, 1, At, B1); G8_BAR;
      G8_LDA(At, 1, 1); G8_STAGE(G8_SA(1, 0), a3);
      G8_BAR; G8_WAIT_L(0); G8_MMA(1, 0, At, B0); G8_BAR; G8_SCHED;
      G8_STAGE(G8_SB(1, 1), b3 + hstep);
      G8_WAIT_V(6); G8_BAR; G8_MMA(1, 1, At, B1); G8_BAR;
    }
    {
      f32x4 pf[4];
      const bool do_pf = Epi::NEED_RSTD && has_next;
      if (do_pf) {
        const f32x4* sp = (const f32x4*)(ssq_in + (size_t)(nxt.pm * 256 + (tid >> 1)) * 32 + (tid & 1) * 16);
#pragma unroll
        for (int i = 0; i < 4; ++i) pf[i] = sp[i];
      }
      E(acc, cur, wr, wc, fr, fq, lane, rstd_s + (ui & 1) * 256);
      if (do_pf) {
        const f32x4 a = (pf[0] + pf[1]) + (pf[2] + pf[3]);
        float t_ = (a[0] + a[1]) + (a[2] + a[3]);
        t_ += __shfl_xor(t_, 1);
        if (!(tid & 1)) rstd_s[((ui + 1) & 1) * 256 + (tid >> 1)] = rsqrtf(t_ * (1.f / 1024.f) + 1e-6f);
      }
    }
    if (!has_next) break;
#pragma unroll
    for (int a = 0; a < 2; ++a)
#pragma unroll
      for (int b = 0; b < 2; ++b)
#pragma unroll
        for (int m = 0; m < 4; ++m)
#pragma unroll
          for (int n = 0; n < 2; ++n) acc[a][b][m][n] = (f32x4){0.f, 0.f, 0.f, 0.f};
    cur = nxt; cA = nA; cB = nB; ++ui;
  }
  G8_WAIT_V(0);
  if (wr == 0) G8_BAR;
  G8_BAR;
#undef G8_SA
#undef G8_SB
#undef G8_STAGE
#undef G8_LDA
#undef G8_LDB
#undef G8_MMA
#undef G8_WAIT_V
#undef G8_WAIT_L
#undef G8_BAR
#undef G8_SCHED
}

typedef f32x4 AccT[2][2][4][2];

struct EpiSwiglu {
  static constexpr bool NEED_RSTD = true;
  bf16_t* hid; const float* ssq;
  __device__ __forceinline__ void operator()(const AccT& acc, const Unit& u, int wr, int wc, int fr, int fq, int lane, const LAS float* rsp) const {
    float rs[2][4];
#pragma unroll
    for (int ai = 0; ai < 2; ++ai)
#pragma unroll
      for (int m = 0; m < 4; ++m) rs[ai][m] = rsp[ai * 128 + wr * 64 + m * 16 + fr];
#pragma unroll
    for (int ai = 0; ai < 2; ++ai)
#pragma unroll
      for (int m = 0; m < 4; ++m) {
        if (m & 1) __builtin_amdgcn_sched_barrier(0);
        const size_t row = (size_t)u.pm * 256 + ai * 128 + wr * 64 + m * 16 + fr; const float r = rs[ai][m];
        u32x4 w;
#pragma unroll
        for (int bj = 0; bj < 2; ++bj) {
          const f32x4 g = acc[ai][bj][m][0] * r, uu = acc[ai][bj][m][1] * r; f32x4 h;
#pragma unroll
          for (int j = 0; j < 4; ++j) h[j] = g[j] * sigmoidf_(g[j]) * uu[j];
          const u32x2 t_ = pk4(h); w[2 * bj] = t_[0]; w[2 * bj + 1] = t_[1];
        }
        *(u32x4*)(hid + row * DFF + u.pn * 128 + wc * 32 + fq * 8) = w;
      }
  }
};

struct EpiNull {
  static constexpr bool NEED_RSTD = false;
  float* dummy; int never;
  __device__ __forceinline__ void operator()(const AccT& acc, const Unit& u, int wr, int wc, int fr, int fq, int lane, const LAS float* rsp) const {
    if (never) { f32x4 s = acc[0][0][0][0];
#pragma unroll
      for (int a = 0; a < 2; ++a)
#pragma unroll
        for (int b = 0; b < 2; ++b)
#pragma unroll
          for (int m = 0; m < 4; ++m)
#pragma unroll
            for (int n = 0; n < 2; ++n) s += acc[a][b][m][n];
      *(f32x4*)(dummy + lane * 4) = s; }
  }
};

struct EpiResid {
  static constexpr bool NEED_RSTD = false;
  bf16_t* xl; bf16_t* xb; float* ssq; float alpha;
  __device__ __forceinline__ void operator()(const AccT& acc, const Unit& u, int wr, int wc, int fr, int fq, int lane, const LAS float* rsp) const {
#pragma unroll
    for (int ai = 0; ai < 2; ++ai)
#pragma unroll
      for (int m = 0; m < 4; ++m) {
        __builtin_amdgcn_sched_barrier(0);
        const size_t row = (size_t)u.pm * 256 + ai * 128 + wr * 64 + m * 16 + fr;
        float sbj[2];
#pragma unroll
        for (int bj = 0; bj < 2; ++bj) {
          const int c = u.pn * 256 + bj * 128 + wc * 32 + fq * 8;
          const u32x4 hq_ = *(const u32x4*)(xb + row * DM + c), lq_ = XLO ? *(const u32x4*)(xl + row * DM + c) : (u32x4){0u, 0u, 0u, 0u};
          f32x4 x0 = hl_join4((u32x2){hq_[0], hq_[1]}, (u32x2){lq_[0], lq_[1]}), x1 = hl_join4((u32x2){hq_[2], hq_[3]}, (u32x2){lq_[2], lq_[3]});
          x0 += acc[ai][bj][m][0] * alpha; x1 += acc[ai][bj][m][1] * alpha;
          { u32x2 h0, l0, h1, l1; hl_split4(x0, h0, l0); hl_split4(x1, h1, l1);
            *(u32x4*)(xb + row * DM + c) = (u32x4){h0[0], h0[1], h1[0], h1[1]};
            if (XLO) *(u32x4*)(xl + row * DM + c) = (u32x4){l0[0], l0[1], l1[0], l1[1]}; }
          float s0 = x0[0] * x0[0] + x0[1] * x0[1] + x0[2] * x0[2] + x0[3] * x0[3] + x1[0] * x1[0] + x1[1] * x1[1] + x1[2] * x1[2] + x1[3] * x1[3];
          s0 += __shfl_xor(s0, 16); s0 += __shfl_xor(s0, 32);
          sbj[bj] = s0;
        }
        if (fq == 0) *(f32x2_t*)(ssq + row * 32 + u.pn * 8 + wc * 2) = (f32x2_t){sbj[0], sbj[1]};
      }
  }
};

struct EpiResidGlu {
  static constexpr bool NEED_RSTD = false;
  bf16_t* xl; bf16_t* xb; float* ssq;
  __device__ __forceinline__ void operator()(const AccT& acc, const Unit& u, int wr, int wc, int fr, int fq, int lane, const LAS float* rsp) const {
#pragma unroll
    for (int ai = 0; ai < 2; ++ai)
#pragma unroll
      for (int m = 0; m < 4; ++m) {
        __builtin_amdgcn_sched_barrier(0);
        const size_t row = (size_t)u.pm * 256 + ai * 128 + wr * 64 + m * 16 + fr;
        const int c = u.pn * 128 + wc * 32 + fq * 8;
        f32x4 xv[2];
        const u32x4 hq_ = *(const u32x4*)(xb + row * DM + c), lq_ = XLO ? *(const u32x4*)(xl + row * DM + c) : (u32x4){0u, 0u, 0u, 0u};
        xv[0] = hl_join4((u32x2){hq_[0], hq_[1]}, (u32x2){lq_[0], lq_[1]}); xv[1] = hl_join4((u32x2){hq_[2], hq_[3]}, (u32x2){lq_[2], lq_[3]});
#pragma unroll
        for (int bj = 0; bj < 2; ++bj)
#pragma unroll
          for (int j = 0; j < 4; ++j) xv[bj][j] += acc[ai][bj][m][0][j] * sigmoidf_(acc[ai][bj][m][1][j]);
        { u32x2 h0, l0, h1, l1; hl_split4(xv[0], h0, l0); hl_split4(xv[1], h1, l1);
          *(u32x4*)(xb + row * DM + c) = (u32x4){h0[0], h0[1], h1[0], h1[1]};
          if (XLO) *(u32x4*)(xl + row * DM + c) = (u32x4){l0[0], l0[1], l1[0], l1[1]}; }
        float s0 = 0.f;
#pragma unroll
        for (int bj = 0; bj < 2; ++bj) s0 += xv[bj][0] * xv[bj][0] + xv[bj][1] * xv[bj][1] + xv[bj][2] * xv[bj][2] + xv[bj][3] * xv[bj][3];
        s0 += __shfl_xor(s0, 16); s0 += __shfl_xor(s0, 32);
        if (fq == 0) ssq[row * 32 + u.pn * 4 + wc] = s0;
      }
  }
};

struct EpiSsmIn {
  static constexpr bool NEED_RSTD = true;
  bf16_t* uf; const float* ssq;
  __device__ __forceinline__ void operator()(const AccT& acc, const Unit& u, int wr, int wc, int fr, int fq, int lane, const LAS float* rsp) const {
    float rs[2][4];
#pragma unroll
    for (int ai = 0; ai < 2; ++ai)
#pragma unroll
      for (int m = 0; m < 4; ++m) rs[ai][m] = rsp[ai * 128 + wr * 64 + m * 16 + fr];
#pragma unroll
    for (int ai = 0; ai < 2; ++ai)
#pragma unroll
      for (int m = 0; m < 4; ++m) {
        const size_t row = (size_t)u.pm * 256 + ai * 128 + wr * 64 + m * 16 + fr; const float r = rs[ai][m];
#pragma unroll
        for (int bj = 0; bj < 2; ++bj) {
          const int c = u.pn * 256 + bj * 128 + wc * 32 + fq * 8;
          const u32x2 a_ = pk4(acc[ai][bj][m][0] * r), b_ = pk4(acc[ai][bj][m][1] * r);
          *(u32x4*)(uf + row * DM + c) = (u32x4){a_[0], a_[1], b_[0], b_[1]};
        }
      }
  }
};

struct EpiAbIn {
  static constexpr bool NEED_RSTD = true;
  bf16_t *qb, *kb, *vb, *zb; const float* rope; float* out; const float* ssq; int li;
  __device__ __forceinline__ void operator()(const AccT& acc, const Unit& u, int wr, int wc, int fr, int fq0, int lane, const LAS float* rsp) const {
    int fq = fq0; asm volatile("" : "+v"(fq));
    float rs[2][4];
#pragma unroll
    for (int ai = 0; ai < 2; ++ai)
#pragma unroll
      for (int m = 0; m < 4; ++m) rs[ai][m] = rsp[ai * 128 + wr * 64 + m * 16 + fr];
#pragma unroll
    for (int ai = 0; ai < 2; ++ai)
#pragma unroll
      for (int m = 0; m < 4; ++m) {
        __builtin_amdgcn_sched_barrier(0);
        const int row = u.pm * 256 + ai * 128 + wr * 64 + m * 16 + fr; const float r = rs[ai][m];
        const bool is_p = row < TP, is_s = (row >= TP) && (row < TT);
        int b = 0, pos = 8192, pidx = SEQL;
        if (is_p) { b = row / SEQL; pos = row - b * SEQL; pidx = pos; } else if (is_s) { b = row - TP; }
        if (u.pn < 3) {
#pragma unroll
          for (int bj = 0; bj < 2; ++bj) {
            const bool isv = (u.pn == 2) && (bj == 1);
            f32x4 v0 = acc[ai][bj][m][0] * r, v1 = acc[ai][bj][m][1] * r;
            if (!isv && ((wc & 1) == 0)) {
              f32x4 o0, o1;
#pragma unroll
              for (int j = 0; j < 4; ++j) { o0[j] = __shfl_xor(v0[j], 16); o1[j] = __shfl_xor(v1[j], 16); }
              const f32x4 c0 = *(const f32x4*)(rope + pidx * 16), c1 = *(const f32x4*)(rope + pidx * 16 + 4);
              const f32x4 s0 = *(const f32x4*)(rope + pidx * 16 + 8), s1 = *(const f32x4*)(rope + pidx * 16 + 12);
              if (fq == 0) { v0 = v0 * c0 - o0 * s0; v1 = v1 * c1 - o1 * s1; }
              else if (fq == 1) { v0 = v0 * c0 + o0 * s0; v1 = v1 * c1 + o1 * s1; }
            }
            u32x4 w; { const u32x2 a_ = pk4(v0), b_ = pk4(v1); w[0] = a_[0]; w[1] = a_[1]; w[2] = b_[0]; w[3] = b_[1]; }
            if (u.pn < 2) {
              *(u32x4*)(qb + (size_t)row * 512 + u.pn * 256 + bj * 128 + wc * 32 + fq * 8) = w;
            } else {
              const int kvh = wc >> 1, d0 = (wc & 1) * 32 + fq * 8;
              *(u32x4*)((isv ? vb : kb) + (size_t)row * 128 + kvh * 64 + d0) = w;
              if (is_p && pos >= SEQL - 128) {
                float* o = out + (isv ? O_PV : O_PK) + ((size_t)((li * 4 + b) * 128 + (pos - (SEQL - 128))) * 2 + kvh) * 64 + d0;
                *(f32x4*)(o) = v0; *(f32x4*)(o + 4) = v1;
              }
              if (is_s) {
                float* o = out + (isv ? O_SV : O_SK) + ((size_t)((li * 128 + b) * 128 + 127) * 2 + kvh) * 64 + d0;
                *(f32x4*)(o) = v0; *(f32x4*)(o + 4) = v1;
              }
            }
          }
        } else {
          f32x4 z[2];
#pragma unroll
          for (int bj = 0; bj < 2; ++bj)
#pragma unroll
            for (int j = 0; j < 4; ++j) z[bj][j] = acc[ai][bj][m][0][j] * r * sigmoidf_(acc[ai][bj][m][1][j] * r);
          const int zc = (u.pn - 3) * 128 + wc * 32 + fq * 8;
          u32x4 w; { const u32x2 a_ = pk4(z[0]), b_ = pk4(z[1]); w[0] = a_[0]; w[1] = a_[1]; w[2] = b_[0]; w[3] = b_[1]; }
          *(u32x4*)(zb + (size_t)row * 512 + zc) = w;
          if (is_p && pos >= SEQL - 30) { float* o = out + O_PCONV + ((size_t)(li * 4 + b) * 30 + (pos - (SEQL - 30))) * 512 + zc; *(f32x4*)o = z[0]; *(f32x4*)(o + 4) = z[1]; }
          if (is_s) { float* o = out + O_SCONV + ((size_t)(li * 128 + b) * 30 + 29) * 512 + zc; *(f32x4*)o = z[0]; *(f32x4*)(o + 4) = z[1]; }
        }
      }
  }
};


__device__ __forceinline__ int wt_row_of_col(int c) { const int c32 = c & 31; return (c & ~31) + 16 * ((c32 >> 2) & 1) + 4 * (c32 >> 3) + (c32 & 3); }

struct MiniResid {
  bf16_t* xl; bf16_t* xb; float* ssq; float alpha;
  __device__ __forceinline__ void operator()(int row, int c0, int fq, const f32x4 (&v)[2]) const {
    float s0 = 0.f;
#pragma unroll
    for (int ct = 0; ct < 2; ++ct) {
      const int c = c0 + 16 * ct + 4 * fq;
      f32x4 xv = hl_join4(*(const u32x2*)(xb + (size_t)row * DM + c), XLO ? *(const u32x2*)(xl + (size_t)row * DM + c) : (u32x2){0u, 0u});
      xv += v[ct] * alpha;
      { u32x2 h_, l_; hl_split4(xv, h_, l_); *(u32x2*)(xb + (size_t)row * DM + c) = h_; if (XLO) *(u32x2*)(xl + (size_t)row * DM + c) = l_; }
      s0 += xv[0] * xv[0] + xv[1] * xv[1] + xv[2] * xv[2] + xv[3] * xv[3];
    }
    s0 += __shfl_xor(s0, 16); s0 += __shfl_xor(s0, 32);
    if (fq == 0) ssq[(size_t)row * 32 + (c0 >> 5)] = s0;
  }
};
struct MiniSsmIn {
  bf16_t* uf; const float* ssq;
  __device__ __forceinline__ void operator()(int row, int c0, int fq, const f32x4 (&v)[2]) const {
    const f32x4* sp = (const f32x4*)(ssq + (size_t)row * 32);
    f32x4 a = sp[0];
#pragma unroll
    for (int i = 1; i < 8; ++i) a += sp[i];
    const float r = rsqrtf((a[0] + a[1] + a[2] + a[3]) * (1.f / 1024.f) + 1e-6f);
#pragma unroll
    for (int ct = 0; ct < 2; ++ct) *(u32x2*)(uf + (size_t)row * DM + c0 + 16 * ct + 4 * fq) = pk4(v[ct] * r);
  }
};

template <class ME>
__device__ __forceinline__ void mini_phase(const bf16_t* __restrict__ A, const bf16_t* __restrict__ Bt, int K, const ME& me, char* shm) {
  int tid = threadIdx.x; asm volatile("" : "+v"(tid));
  const int wave = tid >> 6, lane = tid & 63, fr = lane & 15, fq = lane >> 4;
  float* red = (float*)shm;
  for (int mu = blockIdx.x; mu < 96; mu += gridDim.x) {
    const int rg = mu >> 5, cgi = mu & 31, r0 = 16384 + rg * 64, c0 = cgi * 32;
    const int kw = K >> 3, kb = wave * kw;
    f32x4 acc[4][2];
#pragma unroll
    for (int mt = 0; mt < 4; ++mt) { acc[mt][0] = (f32x4){0.f, 0.f, 0.f, 0.f}; acc[mt][1] = (f32x4){0.f, 0.f, 0.f, 0.f}; }
    const bf16_t* ap = A + (size_t)(r0 + fr) * K + kb + fq * 8;
    const bf16_t* bp0 = Bt + (size_t)wt_row_of_col(c0 + fr) * K + kb + fq * 8;
    const bf16_t* bp1 = Bt + (size_t)wt_row_of_col(c0 + 16 + fr) * K + kb + fq * 8;
    const int nks = kw >> 5;
#pragma unroll 4
    for (int ks = 0; ks < nks; ++ks) {
      const bf16x8 b0 = *(const bf16x8*)(bp0 + ks * 32), b1 = *(const bf16x8*)(bp1 + ks * 32);
#pragma unroll
      for (int mt = 0; mt < 4; ++mt) {
        const bf16x8 a = *(const bf16x8*)(ap + (size_t)mt * 16 * K + ks * 32);
        acc[mt][0] = __builtin_amdgcn_mfma_f32_16x16x32_bf16(b0, a, acc[mt][0], 0, 0, 0);
        acc[mt][1] = __builtin_amdgcn_mfma_f32_16x16x32_bf16(b1, a, acc[mt][1], 0, 0, 0);
      }
    }
    __syncthreads();
#pragma unroll
    for (int mt = 0; mt < 4; ++mt)
#pragma unroll
      for (int ct = 0; ct < 2; ++ct) *(f32x4*)(red + ((wave * 8 + mt * 2 + ct) * 64 + lane) * 4) = acc[mt][ct];
    __syncthreads();
    if (wave < 4) {
      f32x4 v[2];
#pragma unroll
      for (int ct = 0; ct < 2; ++ct) {
        f32x4 t = *(const f32x4*)(red + ((wave * 2 + ct) * 64 + lane) * 4);
#pragma unroll
        for (int w = 1; w < 8; ++w) t += *(const f32x4*)(red + ((w * 8 + wave * 2 + ct) * 64 + lane) * 4);
        v[ct] = t;
      }
      me(r0 + 16 * wave + fr, c0, fq, v);
    }
  }
}


__device__ __forceinline__ int wt_row_glu(int n, int H) {
  const int t = H >> 7, h7 = H & 127;
  return 256 * t + 128 * ((h7 >> 2) & 1) + 32 * (h7 >> 5) + 16 * n + 4 * ((h7 >> 3) & 3) + (h7 & 3);
}
__device__ __forceinline__ void mini_glu_phase(const bf16_t* __restrict__ A, const bf16_t* __restrict__ Bt, bf16_t* xl, bf16_t* xb, float* ssq, char* shm) {
  constexpr int K = 1024;
  int tid = threadIdx.x; asm volatile("" : "+v"(tid));
  const int wave = tid >> 6, lane = tid & 63, fr = lane & 15, fq = lane >> 4;
  float* red = (float*)shm;
  for (int mu = blockIdx.x; mu < 96; mu += gridDim.x) {
    const int rg = mu >> 5, cgi = mu & 31, r0 = 16384 + rg * 64, H0 = cgi * 32;
    const int kb = wave * (K / 8);
    f32x4 acc[4][2][2];
#pragma unroll
    for (int mt = 0; mt < 4; ++mt)
#pragma unroll
      for (int ct = 0; ct < 2; ++ct) { acc[mt][ct][0] = (f32x4){0.f, 0.f, 0.f, 0.f}; acc[mt][ct][1] = (f32x4){0.f, 0.f, 0.f, 0.f}; }
    const bf16_t* ap = A + (size_t)(r0 + fr) * K + kb + fq * 8;
    const bf16_t* bp[2][2];
#pragma unroll
    for (int ct = 0; ct < 2; ++ct)
#pragma unroll
      for (int n = 0; n < 2; ++n) bp[ct][n] = Bt + (size_t)wt_row_glu(n, H0 + 16 * ct + fr) * K + kb + fq * 8;
#pragma unroll
    for (int ks = 0; ks < 4; ++ks) {
      bf16x8 bf[2][2];
#pragma unroll
      for (int ct = 0; ct < 2; ++ct)
#pragma unroll
        for (int n = 0; n < 2; ++n) bf[ct][n] = *(const bf16x8*)(bp[ct][n] + ks * 32);
#pragma unroll
      for (int mt = 0; mt < 4; ++mt) {
        const bf16x8 a = *(const bf16x8*)(ap + (size_t)mt * 16 * K + ks * 32);
#pragma unroll
        for (int ct = 0; ct < 2; ++ct)
#pragma unroll
          for (int n = 0; n < 2; ++n) acc[mt][ct][n] = __builtin_amdgcn_mfma_f32_16x16x32_bf16(bf[ct][n], a, acc[mt][ct][n], 0, 0, 0);
      }
    }
    __syncthreads();
#pragma unroll
    for (int mt = 0; mt < 4; ++mt)
#pragma unroll
      for (int ct = 0; ct < 2; ++ct)
#pragma unroll
        for (int n = 0; n < 2; ++n) *(f32x4*)(red + ((wave * 16 + mt * 4 + ct * 2 + n) * 64 + lane) * 4) = acc[mt][ct][n];
    __syncthreads();
    if (wave < 4) {
      const int row = r0 + 16 * wave + fr;
      float s0 = 0.f;
#pragma unroll
      for (int ct = 0; ct < 2; ++ct) {
        f32x4 val = (f32x4){0.f, 0.f, 0.f, 0.f}, gate = (f32x4){0.f, 0.f, 0.f, 0.f};
#pragma unroll
        for (int w = 0; w < 8; ++w) {
          val += *(const f32x4*)(red + ((w * 16 + wave * 4 + ct * 2 + 0) * 64 + lane) * 4);
          gate += *(const f32x4*)(red + ((w * 16 + wave * 4 + ct * 2 + 1) * 64 + lane) * 4);
        }
        const int c = H0 + 16 * ct + 4 * fq;
        f32x4 xv = hl_join4(*(const u32x2*)(xb + (size_t)row * DM + c), XLO ? *(const u32x2*)(xl + (size_t)row * DM + c) : (u32x2){0u, 0u});
#pragma unroll
        for (int j = 0; j < 4; ++j) xv[j] += val[j] * sigmoidf_(gate[j]);
        { u32x2 h_, l_; hl_split4(xv, h_, l_); *(u32x2*)(xb + (size_t)row * DM + c) = h_; if (XLO) *(u32x2*)(xl + (size_t)row * DM + c) = l_; }
        s0 += xv[0] * xv[0] + xv[1] * xv[1] + xv[2] * xv[2] + xv[3] * xv[3];
      }
      s0 += __shfl_xor(s0, 16); s0 += __shfl_xor(s0, 32);
      if (fq == 0) ssq[(size_t)row * 32 + cgi] = s0;
    }
  }
}

__device__ __forceinline__ int src_col(int R, int start, int lo, int hi) {
  if (R >= start) {
    const int rp = R - start, t = rp >> 8, cl = rp & 255;
    const int bj = cl >> 7, wc = (cl >> 5) & 3, n = (cl >> 4) & 1, fq = (cl >> 2) & 3, j = cl & 3;
    return (n ? hi : lo) + 128 * t + 32 * wc + 8 * fq + 4 * bj + j;
  }
  const int cl = R & 31, n = cl >> 4, i = cl & 15;
  return (R & ~31) + 8 * (i >> 2) + 4 * n + (i & 3);
}

__device__ __forceinline__ void convert_mat(const float* __restrict__ src, bf16_t* __restrict__ dst, int K, int N,
                                            int start, int lo, int hi, const float* __restrict__ gvec, float* tile) {
  const int ntk = K / 64, ntn = N / 64, ntile = ntk * ntn;
  const int tid = threadIdx.x;
  const int q = tid & 15, kq = tid >> 4;
  const int n = tid >> 3, k8 = (tid & 7) * 8;
  f32x4 v0, v1; float g0 = 1.f, g1 = 1.f;
  int tI = blockIdx.x;
  if (tI < ntile) {
    const int tn = tI / ntk, tk = tI % ntk, col = src_col(tn * 64 + 4 * q, start, lo, hi), k = tk * 64 + kq;
    v0 = *(const f32x4*)(src + (size_t)k * N + col); v1 = *(const f32x4*)(src + (size_t)(k + 32) * N + col);
    if (gvec) { g0 = gvec[k]; g1 = gvec[k + 32]; }
  }
  for (; tI < ntile; tI += gridDim.x) {
    const int tn = tI / ntk, tk = tI % ntk, r0 = tn * 64, k0 = tk * 64;
    const f32x4 c0 = v0 * g0, c1 = v1 * g1;
    const int tN = tI + gridDim.x;
    if (tN < ntile) {
      const int tn2 = tN / ntk, tk2 = tN % ntk, col = src_col(tn2 * 64 + 4 * q, start, lo, hi), k = tk2 * 64 + kq;
      v0 = *(const f32x4*)(src + (size_t)k * N + col); v1 = *(const f32x4*)(src + (size_t)(k + 32) * N + col);
      if (gvec) { g0 = gvec[k]; g1 = gvec[k + 32]; }
    }
    { float* tp = tile + kq * 65 + 4 * q; tp[0] = c0[0]; tp[1] = c0[1]; tp[2] = c0[2]; tp[3] = c0[3];
      tp += 32 * 65; tp[0] = c1[0]; tp[1] = c1[1]; tp[2] = c1[2]; tp[3] = c1[3]; }
    __syncthreads();
    {
      u32x4 w;
#pragma unroll
      for (int i = 0; i < 4; ++i) w[i] = pk_bf16(tile[(k8 + 2 * i) * 65 + n], tile[(k8 + 2 * i + 1) * 65 + n]);
      *(u32x4*)(dst + (size_t)(r0 + n) * K + k0 + k8) = w;
    }
    __syncthreads();
  }
}

__device__ __forceinline__ void phase_init(const P& p, float* tile) {
  const int wave = threadIdx.x >> 6, lane = threadIdx.x & 63;
  bf16_t* xl = (bf16_t*)(p.ws + B_X); bf16_t* xb = (bf16_t*)(p.ws + B_XB); float* ssq = (float*)(p.ws + B_SSQ);
  float* rope = (float*)(p.ws + B_ROPE);
  for (int row = blockIdx.x * 8 + wave; row < TPAD; row += gridDim.x * 8) {
    const float* src = nullptr;
    if (row < TP) { const int b = row / SEQL, pos = row - b * SEQL; src = (pos < 16) ? (p.in[7] + pos * DM) : (p.in[0] + ((size_t)b * 4096 + (pos - 16)) * DM); }
    else if (row < TT) src = p.in[1] + (size_t)(row - TP) * DM;
    float ss = 0.f;
#pragma unroll
    for (int i = 0; i < 4; ++i) {
      const int c = (i * 64 + lane) * 4;
      f32x4 v = (f32x4){0.f, 0.f, 0.f, 0.f};
      if (src) v = *(const f32x4*)(src + c);
      { u32x2 h_, l_; hl_split4(v, h_, l_); *(u32x2*)(xb + (size_t)row * DM + c) = h_; if (XLO) *(u32x2*)(xl + (size_t)row * DM + c) = l_; }
      ss += v[0] * v[0] + v[1] * v[1] + v[2] * v[2] + v[3] * v[3];
    }
    ss += __shfl_xor(ss, 1);
    if (!(lane & 1)) ssq[(size_t)row * 32 + (lane >> 1)] = ss;
  }
  for (int e = blockIdx.x * 512 + threadIdx.x; e < 4113 * 8; e += gridDim.x * 512) {
    const int pi = e >> 3, j = e & 7;
    const double inv[8] = {1.0, 0.19392274474868576, 0.03760603093086393, 0.007292664737217109,
                           0.001414213562373095, 0.0002742481756762073, 5.318295896944988e-05, 1.031338537721246e-05};
    double iv = inv[0];
#pragma unroll
    for (int q = 1; q < 8; ++q) iv = (j == q) ? inv[q] : iv;
    const double pos = (pi == SEQL) ? 8192.0 : (double)pi;
    const double ang = pos * iv;
    const double n = __builtin_rint(ang * 0.15915494309189535);
    const float rf = (float)(ang - n * 6.283185307179586);
    rope[pi * 16 + j] = cosf(rf);
    rope[pi * 16 + 8 + j] = sinf(rf);
  }
  const float* ng = p.in[8];
  for (int l = 0; l < 4; ++l) {
    convert_mat(p.in[10] + (size_t)l * 1024 * 5632, (bf16_t*)(p.ws + W_GU + (size_t)(l * 2 + 0) * SZ_GU), 1024, 5632, 0, 0, 2816, ng + (l * 3 + 0) * 1024, tile);
    convert_mat(p.in[12] + (size_t)l * 1024 * 5632, (bf16_t*)(p.ws + W_GU + (size_t)(l * 2 + 1) * SZ_GU), 1024, 5632, 0, 0, 2816, ng + (l * 3 + 2) * 1024, tile);
    convert_mat(p.in[11] + (size_t)l * 2816 * 1024, (bf16_t*)(p.ws + W_DOWN + (size_t)(l * 2 + 0) * SZ_DOWN), 2816, 1024, 1 << 30, 0, 0, nullptr, tile);
    convert_mat(p.in[13] + (size_t)l * 2816 * 1024, (bf16_t*)(p.ws + W_DOWN + (size_t)(l * 2 + 1) * SZ_DOWN), 2816, 1024, 1 << 30, 0, 0, nullptr, tile);
    const int i = l >> 1;
    if ((l & 1) == 0) {
      convert_mat(p.in[14] + (size_t)i * 1024 * 1792, (bf16_t*)(p.ws + W_ABIN + (size_t)i * SZ_ABIN), 1024, 1792, 768, 768, 1280, ng + (l * 3 + 1) * 1024, tile);
      convert_mat(p.in[15] + (size_t)i * 1024 * 1024, (bf16_t*)(p.ws + W_ABOUT + (size_t)i * SZ_SQ), 1024, 1024, 1 << 30, 0, 0, nullptr, tile);
    } else {
      convert_mat(p.in[21] + (size_t)i * 1024 * 1024, (bf16_t*)(p.ws + W_SSMIN + (size_t)i * SZ_SQ), 1024, 1024, 1 << 30, 0, 0, ng + (l * 3 + 1) * 1024, tile);
      convert_mat(p.in[30] + (size_t)i * 1024 * 2048, (bf16_t*)(p.ws + W_GLU + (size_t)i * SZ_GLU), 1024, 2048, 0, 0, 1024, nullptr, tile);
    }
  }
}

__device__ __forceinline__ void phase_final(const P& p) {
  const int wave = threadIdx.x >> 6, lane = threadIdx.x & 63;
  const bf16_t* xl = (const bf16_t*)(p.ws + B_X); const bf16_t* xb = (const bf16_t*)(p.ws + B_XB); const float* ssq = (const float*)(p.ws + B_SSQ);
  const float* g = p.in[9];
  for (int row = blockIdx.x * 8 + wave; row < TT; row += gridDim.x * 8) {
    float* dst;
    if (row < TP) { const int b = row / SEQL, pos = row - b * SEQL; if (pos < 16) continue; dst = p.out + O_YP + ((size_t)b * 4096 + (pos - 16)) * DM; }
    else dst = p.out + O_YS + (size_t)(row - TP) * DM;
    float s = (lane < 32) ? ssq[(size_t)row * 32 + lane] : 0.f;
#pragma unroll
    for (int o = 32; o >= 1; o >>= 1) s += __shfl_xor(s, o);
    const float r = rsqrtf(s * (1.f / 1024.f) + 1e-6f);
#pragma unroll
    for (int i = 0; i < 4; ++i) {
      const int c = (i * 64 + lane) * 4;
      f32x4 v = hl_join4(*(const u32x2*)(xb + (size_t)row * DM + c), XLO ? *(const u32x2*)(xl + (size_t)row * DM + c) : (u32x2){0u, 0u});
      const f32x4 gg = *(const f32x4*)(g + c);
      *(f32x4*)(dst + c) = v * r * gg;
    }
  }
}

constexpr int VST = 164;

__device__ __forceinline__ void phase_mix_ab(const P& p, int li, char* shm) {
  int tid = threadIdx.x; asm volatile("" : "+v"(tid));
  const int wave = tid >> 6, lane = tid & 63, fr = lane & 15, fq = lane >> 4;
  const bf16_t* qb = (const bf16_t*)(p.ws + B_QB); const bf16_t* kb = (const bf16_t*)(p.ws + B_KB);
  const bf16_t* vb = (const bf16_t*)(p.ws + B_VB); const bf16_t* zb = (const bf16_t*)(p.ws + B_ZB);
  bf16_t* cat = (bf16_t*)(p.ws + B_CAT);
  const float* sinkp = p.in[16] + li * 8;
  constexpr int NU_AP = 4 * 129, NU_AS = 128, NU_CP = 4 * 129, NU_CS = 32;
  constexpr int NU = NU_AP + NU_AS + NU_CP + NU_CS;
  for (int unit0 = blockIdx.x; unit0 < NU; unit0 += gridDim.x) {
    __syncthreads();
    const int unit = (unit0 < NU_AS) ? (NU_AP + unit0) : (unit0 < NU_AS + NU_CS) ? (NU_AP + NU_AS + NU_CP + (unit0 - NU_AS)) : (unit0 < NU_AS + NU_CS + NU_AP) ? (unit0 - NU_AS - NU_CS) : (NU_AP + NU_AS + (unit0 - NU_AS - NU_CS - NU_AP));
    if (unit < NU_AP) {
#if !NOATTN
      const int b = unit / 129, qt = unit % 129, q0 = qt * 32, k0 = q0 - 128;
      bf16_t* Vt = (bf16_t*)shm;
      const int hq = wave, kvh = hq >> 2;
      const float sink = sinkp[hq];
      u32x4 vreg[5];
#pragma unroll
      for (int it = 0; it < 5; ++it) {
        const int idx = it * 512 + tid, key = idx >> 4, dc = (idx & 15) * 8, kp = k0 + key;
        vreg[it] = (u32x4){0u, 0u, 0u, 0u};
        if (kp >= 0 && kp < SEQL) vreg[it] = *(const u32x4*)(vb + (size_t)(b * SEQL + kp) * 128 + dc);
      }
      bf16x8 Qf[2][2];
#pragma unroll
      for (int q2 = 0; q2 < 2; ++q2) {
        const int qp = min(q0 + 16 * q2 + fr, SEQL - 1);
#pragma unroll
        for (int kk = 0; kk < 2; ++kk) Qf[q2][kk] = *(const bf16x8*)(qb + (size_t)(b * SEQL + qp) * 512 + hq * 64 + kk * 32 + fq * 8);
      }
      bf16x8 Kf[5][2];
#pragma unroll
      for (int kt = 0; kt < 5; ++kt) {
        const int kp = min(max(k0 + 16 * kt + fr, 0), SEQL - 1);
        const bf16_t* kr = kb + (size_t)(b * SEQL + kp) * 128 + kvh * 64 + fq * 8;
        Kf[kt][0] = *(const bf16x8*)(kr); Kf[kt][1] = *(const bf16x8*)(kr + 32);
      }
#pragma unroll
      for (int it = 0; it < 5; ++it) {
        const int idx = it * 512 + tid, key = idx >> 4, dc = (idx & 15) * 8;
        const u32x4 v = vreg[it];
#pragma unroll
        for (int e = 0; e < 4; ++e) {
          Vt[(dc + 2 * e) * VST + key] = (bf16_t)(v[e] & 0xffff);
          Vt[(dc + 2 * e + 1) * VST + key] = (bf16_t)(v[e] >> 16);
        }
      }
      __syncthreads();
      f32x4 s[10][2];
#pragma unroll
      for (int kt = 0; kt < 10; ++kt) {
        bf16x8 K0, K1;
        if (kt < 5) { K0 = Kf[kt % 5][0]; K1 = Kf[kt % 5][1]; }
        else {
          const int kp = min(max(k0 + 16 * kt + fr, 0), SEQL - 1);
          const bf16_t* kr = kb + (size_t)(b * SEQL + kp) * 128 + kvh * 64 + fq * 8;
          K0 = *(const bf16x8*)(kr); K1 = *(const bf16x8*)(kr + 32);
        }
#pragma unroll
        for (int q2 = 0; q2 < 2; ++q2) {
          f32x4 a = (f32x4){0.f, 0.f, 0.f, 0.f};
          a = __builtin_amdgcn_mfma_f32_16x16x32_bf16(K0, Qf[q2][0], a, 0, 0, 0);
          a = __builtin_amdgcn_mfma_f32_16x16x32_bf16(K1, Qf[q2][1], a, 0, 0, 0);
          s[kt][q2] = a;
        }
      }
      float invl[2];
#pragma unroll
      for (int q2 = 0; q2 < 2; ++q2) {
        const int qp = q0 + 16 * q2 + fr;
        float mx = sink;
#pragma unroll
        for (int kt = 0; kt < 10; ++kt)
#pragma unroll
          for (int j = 0; j < 4; ++j) {
            const int kp = k0 + 16 * kt + 4 * fq + j, diff = qp - kp;
            const bool valid = (kp >= 0) && (diff >= 0) && (diff <= 128);
            const float sc = valid ? s[kt][q2][j] * 0.125f : -1e30f;
            s[kt][q2][j] = sc;
            mx = fmaxf(mx, sc);
          }
        mx = fmaxf(mx, __shfl_xor(mx, 16)); mx = fmaxf(mx, __shfl_xor(mx, 32));
        float l = 0.f;
#pragma unroll
        for (int kt = 0; kt < 10; ++kt)
#pragma unroll
          for (int j = 0; j < 4; ++j) {
            const float sc = s[kt][q2][j];
            const float pv = (sc > -1e29f) ? fexp(sc - mx) : 0.f;
            s[kt][q2][j] = pv; l += pv;
          }
        l += __shfl_xor(l, 16); l += __shfl_xor(l, 32);
        l += fexp(sink - mx);
        invl[q2] = 1.f / l;
      }
      f32x4 o[4][2];
#pragma unroll
      for (int dt = 0; dt < 4; ++dt)
#pragma unroll
        for (int q2 = 0; q2 < 2; ++q2) o[dt][q2] = (f32x4){0.f, 0.f, 0.f, 0.f};
#pragma unroll
      for (int ks = 0; ks < 5; ++ks) {
        bf16x8 Pf[2];
#pragma unroll
        for (int q2 = 0; q2 < 2; ++q2) {
          u32x4 w;
          w[0] = pk_bf16(s[2 * ks][q2][0], s[2 * ks][q2][1]); w[1] = pk_bf16(s[2 * ks][q2][2], s[2 * ks][q2][3]);
          w[2] = pk_bf16(s[2 * ks + 1][q2][0], s[2 * ks + 1][q2][1]); w[3] = pk_bf16(s[2 * ks + 1][q2][2], s[2 * ks + 1][q2][3]);
          Pf[q2] = __builtin_bit_cast(bf16x8, w);
        }
#pragma unroll
        for (int dt = 0; dt < 4; ++dt) {
          const int d = kvh * 64 + 16 * dt + fr;
          const u32x2 v0 = *(const u32x2*)(Vt + d * VST + 32 * ks + 4 * fq);
          const u32x2 v1 = *(const u32x2*)(Vt + d * VST + 32 * ks + 16 + 4 * fq);
          u32x4 w; w[0] = v0[0]; w[1] = v0[1]; w[2] = v1[0]; w[3] = v1[1];
          const bf16x8 Vf = __builtin_bit_cast(bf16x8, w);
#pragma unroll
          for (int q2 = 0; q2 < 2; ++q2) o[dt][q2] = __builtin_amdgcn_mfma_f32_16x16x32_bf16(Vf, Pf[q2], o[dt][q2], 0, 0, 0);
        }
      }
      int fr2 = fr, fq2 = fq; asm volatile("" : "+v"(fr2), "+v"(fq2));
#pragma unroll
      for (int q2 = 0; q2 < 2; ++q2) {
        const int qp = q0 + 16 * q2 + fr2;
        if (qp < SEQL) {
          bf16_t* dst = cat + (size_t)(b * SEQL + qp) * 1024 + hq * 64 + 4 * fq2;
#pragma unroll
          for (int dt = 0; dt < 4; ++dt) *(u32x2*)(dst + 16 * dt) = pk4(o[dt][q2] * invl[q2]);
        }
      }
#endif
    } else if (unit < NU_AP + NU_AS) {
#if !NOATTS
      const int sb = unit - NU_AP, hq = wave, kvh = hq >> 2;
      float* qs = (float*)shm + wave * 256;
      float* ps = qs + 64;
      const float* ck = p.in[3] + (size_t)(li * 128 + sb) * 128 * 128;
      const float* cv = p.in[4] + (size_t)(li * 128 + sb) * 128 * 128;
      float* ok = p.out + O_SK + (size_t)(li * 128 + sb) * 128 * 128;
      float* ov = p.out + O_SV + (size_t)(li * 128 + sb) * 128 * 128;
      qs[lane] = bf2f(qb[(size_t)(TP + sb) * 512 + hq * 64 + lane]);
      asm volatile("" ::: "memory");
      const float sink = sinkp[hq];
      float s0, s1, s2;
      {
        const float* kr0 = ck + (size_t)lane * 128 + kvh * 64;
        const float* kr1 = kr0 + 64 * 128;
        float a0 = 0.f, a1 = 0.f;
#pragma unroll
        for (int d4 = 0; d4 < 16; ++d4) {
          const f32x4 k0 = *(const f32x4*)(kr0 + d4 * 4), k1 = *(const f32x4*)(kr1 + d4 * 4);
          const f32x4 qv = *(const f32x4*)(qs + d4 * 4);
          a0 += k0[0] * qv[0] + k0[1] * qv[1] + k0[2] * qv[2] + k0[3] * qv[3];
          a1 += k1[0] * qv[0] + k1[1] * qv[1] + k1[2] * qv[2] + k1[3] * qv[3];
        }
        const f32x4 kn = *(const f32x4*)(ok + (size_t)127 * 128 + kvh * 64 + (lane & 15) * 4);
        const f32x4 qn = *(const f32x4*)(qs + (lane & 15) * 4);
        float a2 = kn[0] * qn[0] + kn[1] * qn[1] + kn[2] * qn[2] + kn[3] * qn[3];
        a2 += __shfl_xor(a2, 8); a2 += __shfl_xor(a2, 4); a2 += __shfl_xor(a2, 2); a2 += __shfl_xor(a2, 1);
        s0 = a0 * 0.125f; s1 = a1 * 0.125f; s2 = (lane == 0) ? a2 * 0.125f : -1e30f;
      }
      float mx = fmaxf(fmaxf(s0, s1), fmaxf(s2, sink));
#pragma unroll
      for (int o = 32; o >= 1; o >>= 1) mx = fmaxf(mx, __shfl_xor(mx, o));
      const float p0 = fexp(s0 - mx), p1 = fexp(s1 - mx), p2 = (lane == 0) ? fexp(s2 - mx) : 0.f;
      ps[lane] = p0; ps[lane + 64] = p1; if (lane == 0) ps[128] = p2;
      float l = p0 + p1 + p2;
#pragma unroll
      for (int o = 32; o >= 1; o >>= 1) l += __shfl_xor(l, o);
      l += fexp(sink - mx);
      asm volatile("" ::: "memory");
      {
        const int g = lane >> 4, d4 = (lane & 15) * 4;
        f32x4 acc = (f32x4){0.f, 0.f, 0.f, 0.f};
#pragma unroll 8
        for (int it = 0; it < 32; ++it) {
          const int key = it * 4 + g;
          const f32x4 vv = *(const f32x4*)(cv + (size_t)key * 128 + kvh * 64 + d4);
          acc += vv * ps[key];
        }
        if (g == 0) { const f32x4 vn = *(const f32x4*)(ov + (size_t)127 * 128 + kvh * 64 + d4); acc += vn * ps[128]; }
#pragma unroll
        for (int j = 0; j < 4; ++j) { acc[j] += __shfl_xor(acc[j], 16); acc[j] += __shfl_xor(acc[j], 32); }
        if (g == 0) *(u32x2*)(cat + (size_t)(TP + sb) * 1024 + hq * 64 + d4) = pk4(acc * (1.f / l));
      }
      {
        f32x4 tk[8], tv[8];
#pragma unroll
        for (int it = 0; it < 8; ++it) {
          const int e = it * 512 + tid;
          if (e < 127 * 32) { tk[it] = *(const f32x4*)(ck + 128 + (size_t)e * 4); tv[it] = *(const f32x4*)(cv + 128 + (size_t)e * 4); }
        }
#pragma unroll
        for (int it = 0; it < 8; ++it) {
          const int e = it * 512 + tid;
          if (e < 127 * 32) { *(f32x4*)(ok + (size_t)e * 4) = tk[it]; *(f32x4*)(ov + (size_t)e * 4) = tv[it]; }
        }
      }
#endif
    } else {
#if !NOCONV
      const int cu = unit - NU_AP - NU_AS;
      int c = tid; asm volatile("" : "+v"(c));
      float* ys = (float*)shm;
      const float* cw = p.in[17] + (size_t)li * 31 * 512;
      float w[31];
#pragma unroll
      for (int j = 0; j < 31; ++j) w[j] = cw[j * 512 + c];
      const float bias = p.in[18][li * 512 + c];
      int tok0;
      int nvalid = 32; bool is_samp = false;
      if (cu < NU_CP) {
        const int b = cu / 129, tt = cu % 129, t0 = tt * 32;
        tok0 = b * SEQL + t0;
        nvalid = min(32, SEQL - t0);
        float zr[62];
#pragma unroll
        for (int j = 0; j < 62; ++j) {
          const int pos = t0 - 30 + j;
          zr[j] = (pos >= 0 && pos < SEQL) ? bf2f(zb[(size_t)(b * SEQL + pos) * 512 + c]) : 0.f;
        }
#pragma unroll
        for (int t = 0; t < 32; ++t) {
          float y = bias;
#pragma unroll
          for (int j = 0; j < 31; ++j) y += w[j] * zr[t + j];
          ys[t * 512 + c] = y;
        }
      } else {
        const int su = cu - NU_CP;
        tok0 = TP + su * 4;
        nvalid = 4; is_samp = true;
#pragma unroll
        for (int t = 0; t < 4; ++t) {
          const int sb = su * 4 + t;
          const float* st = p.in[2] + (size_t)(li * 128 + sb) * 30 * 512 + c;
          float* so = p.out + O_SCONV + (size_t)(li * 128 + sb) * 30 * 512 + c;
          float y = bias + w[0] * st[0];
#pragma unroll
          for (int j = 1; j < 30; ++j) { const float v = st[j * 512]; y += w[j] * v; so[(j - 1) * 512] = v; }
          y += w[30] * so[29 * 512];
          ys[t * 512 + c] = y;
        }
      }
      __syncthreads();
      int lane8 = lane * 8; asm volatile("" : "+v"(lane8));
      const float* lg = p.in[19] + li * 512 + lane8; const float* lb = p.in[20] + li * 512 + lane8;
      const f32x4 g0 = *(const f32x4*)lg, g1 = *(const f32x4*)(lg + 4), b0 = *(const f32x4*)lb, b1 = *(const f32x4*)(lb + 4);
#pragma unroll
      for (int q = 0; q < 4; ++q) {
        const int t = is_samp ? ((q == 0 && wave < 4) ? wave : 32) : (wave * 4 + q);
        if (t >= nvalid) continue;
        const f32x4 y0 = *(const f32x4*)(ys + t * 512 + lane * 8), y1 = *(const f32x4*)(ys + t * 512 + lane * 8 + 4);
        float s = y0[0] + y0[1] + y0[2] + y0[3] + y1[0] + y1[1] + y1[2] + y1[3];
#pragma unroll
        for (int o = 32; o >= 1; o >>= 1) s += __shfl_xor(s, o);
        const float mu = s * (1.f / 512.f);
        const f32x4 d0 = y0 - mu, d1 = y1 - mu;
        float vs = d0[0] * d0[0] + d0[1] * d0[1] + d0[2] * d0[2] + d0[3] * d0[3] + d1[0] * d1[0] + d1[1] * d1[1] + d1[2] * d1[2] + d1[3] * d1[3];
#pragma unroll
        for (int o = 32; o >= 1; o >>= 1) vs += __shfl_xor(vs, o);
        const float rs = rsqrtf(vs * (1.f / 512.f) + 1e-6f);
        f32x4 o0 = d0 * rs * g0 + b0, o1 = d1 * rs * g1 + b1;
#pragma unroll
        for (int j = 0; j < 4; ++j) { o0[j] = o0[j] * sigmoidf_(o0[j]); o1[j] = o1[j] * sigmoidf_(o1[j]); }
        if (t < nvalid) {
          u32x4 wv; const u32x2 a = pk4(o0), bq = pk4(o1); wv[0] = a[0]; wv[1] = a[1]; wv[2] = bq[0]; wv[3] = bq[1];
          *(u32x4*)(cat + (size_t)(tok0 + t) * 1024 + 512 + lane * 8) = wv;
        }
      }
#endif
    }
  }
}

struct SsmLane { float lr, li, bbr[16], bbi[16]; };

__device__ __forceinline__ void ssm_lane_params(const P& p, int li_, int g, int lane, SsmLane& o) {
  const float are = p.in[22][(li_ * 64 + g) * 64 + lane], aim = p.in[23][(li_ * 64 + g) * 64 + lane];
  const float dt = expf(p.in[24][li_ * 64 + g]);
  const float mag = expf(are * dt), ang = aim * dt;
  o.lr = mag * cosf(ang); o.li = mag * sinf(ang);
  const float den = are * are + aim * aim, nr = o.lr - 1.f;
  const float fre = (nr * are + o.li * aim) / den, fim = (o.li * are - nr * aim) / den;
  const float* br = p.in[25] + ((size_t)(li_ * 64 + g) * 64 + lane) * 16;
  const float* bi = p.in[26] + ((size_t)(li_ * 64 + g) * 64 + lane) * 16;
#pragma unroll
  for (int c4 = 0; c4 < 4; ++c4) {
    const f32x4 r4 = *(const f32x4*)(br + c4 * 4), i4 = *(const f32x4*)(bi + c4 * 4);
#pragma unroll
    for (int j = 0; j < 4; ++j) {
      o.bbr[c4 * 4 + j] = fre * r4[j] - fim * i4[j];
      o.bbi[c4 * 4 + j] = fre * i4[j] + fim * r4[j];
    }
  }
}

__device__ __forceinline__ void phase_ssm(const P& p, int li_, char* shm) {
  int tid = threadIdx.x; asm volatile("" : "+v"(tid));
  const int wave = tid >> 6, lane = tid & 63, fr = lane & 15, fq = lane >> 4;
  const bf16_t* uf = (const bf16_t*)(p.ws + B_UF);
  bf16_t* yb = (bf16_t*)(p.ws + B_CAT);
  const float* cre = p.in[27] + (size_t)li_ * 64 * 16 * 64; const float* cim = p.in[28] + (size_t)li_ * 64 * 16 * 64;
  const float* dsk = p.in[29] + li_ * 1024;
  float* u_s = (float*)(shm + wave * 13824);
  bf16_t* h_s = (bf16_t*)(shm + wave * 13824 + 1024);
  float* x_s = (float*)(shm + wave * 13824 + 1024 + 4352);
  float* xch = (float*)(shm + 8 * 13824);
  for (int unit = blockIdx.x; unit < 256; unit += gridDim.x) {
    const int b = unit >> 6, g = ((unit & 7) << 3) | ((unit >> 3) & 7);
    const float dt = expf(p.in[24][li_ * 64 + g]);
    float lr, li;
    { const float are = p.in[22][(li_ * 64 + g) * 64 + lane], aim = p.in[23][(li_ * 64 + g) * 64 + lane];
      const float mag = expf(are * dt), ang = aim * dt; lr = mag * cosf(ang); li = mag * sinf(ang); }
    float l16r = lr, l16i = li;
#pragma unroll
    for (int q = 0; q < 4; ++q) { const float nr_ = l16r * l16r - l16i * l16i, ni_ = 2.f * l16r * l16i; l16r = nr_; l16i = ni_; }
    bf16x8 bfrag[8];
#pragma unroll
    for (int q = 0; q < 4; ++q) {
      const int ps = 16 * q + fr;
      const float are = p.in[22][(li_ * 64 + g) * 64 + ps], aim = p.in[23][(li_ * 64 + g) * 64 + ps];
      const float mag = expf(are * dt), ang = aim * dt, l_r = mag * cosf(ang), l_i = mag * sinf(ang);
      const float den = are * are + aim * aim, nr = l_r - 1.f;
      const float fre = (nr * are + l_i * aim) / den, fim = (l_i * are - nr * aim) / den;
      u32x4 wr_ = (u32x4){0u, 0u, 0u, 0u}, wi_ = (u32x4){0u, 0u, 0u, 0u};
      if (fq < 2) {
        const float* br = p.in[25] + ((size_t)(li_ * 64 + g) * 64 + ps) * 16 + fq * 8;
        const float* bi = p.in[26] + ((size_t)(li_ * 64 + g) * 64 + ps) * 16 + fq * 8;
        const f32x4 r0 = *(const f32x4*)br, r1 = *(const f32x4*)(br + 4), i0 = *(const f32x4*)bi, i1 = *(const f32x4*)(bi + 4);
        const f32x4 re0 = r0 * fre - i0 * fim, re1 = r1 * fre - i1 * fim, im0 = i0 * fre + r0 * fim, im1 = i1 * fre + r1 * fim;
        wr_[0] = pk_bf16(re0[0], re0[1]); wr_[1] = pk_bf16(re0[2], re0[3]); wr_[2] = pk_bf16(re1[0], re1[1]); wr_[3] = pk_bf16(re1[2], re1[3]);
        wi_[0] = pk_bf16(im0[0], im0[1]); wi_[1] = pk_bf16(im0[2], im0[3]); wi_[2] = pk_bf16(im1[0], im1[1]); wi_[3] = pk_bf16(im1[2], im1[3]);
      }
      bfrag[q] = __builtin_bit_cast(bf16x8, wr_); bfrag[4 + q] = __builtin_bit_cast(bf16x8, wi_);
    }
    bf16x8 cfrag[4];
#pragma unroll
    for (int kk = 0; kk < 4; ++kk) {
      const int k = kk * 32 + fq * 8;
      const float* src = (k < 64) ? (cre + ((size_t)(g * 16 + fr)) * 64 + k) : (cim + ((size_t)(g * 16 + fr)) * 64 + (k - 64));
      const float sg = (k < 64) ? 1.f : -1.f;
      const f32x4 a = *(const f32x4*)src * sg, c2 = *(const f32x4*)(src + 4) * sg;
      u32x4 w; w[0] = pk_bf16(a[0], a[1]); w[1] = pk_bf16(a[2], a[3]); w[2] = pk_bf16(c2[0], c2[1]); w[3] = pk_bf16(c2[2], c2[3]);
      cfrag[kk] = __builtin_bit_cast(bf16x8, w);
    }
    const f32x4 dsk4 = *(const f32x4*)(dsk + g * 16 + fq * 4);
    const int t0 = wave * 512, nsub = (wave == 7) ? 33 : 32;
    const bf16_t* ubase = uf + ((size_t)(b * SEQL + t0)) * DM + g * 16;
    float hr = 0.f, hi = 0.f, pr = 1.f, pi = 0.f;
#pragma unroll 1
    for (int pass = 0; pass < 2; ++pass) {
      u32x2 unext = *(const u32x2*)(ubase + (size_t)(lane >> 2) * DM + (lane & 3) * 4);
      for (int sbk = 0; sbk < nsub; ++sbk) {
        { f32x4 v; v[0] = bfw_lo(unext[0]); v[1] = bfw_hi(unext[0]); v[2] = bfw_lo(unext[1]); v[3] = bfw_hi(unext[1]);
          if (sbk + 1 < nsub) unext = *(const u32x2*)(ubase + (size_t)((sbk + 1) * 16 + (lane >> 2)) * DM + (lane & 3) * 4);
          asm volatile("" ::: "memory");
          *(f32x4*)(u_s + (lane >> 2) * 16 + (lane & 3) * 4) = v; }
        asm volatile("" ::: "memory");
        {
          u32x4 uw = (u32x4){0u, 0u, 0u, 0u};
          if (fq < 2) {
            const f32x4 a = *(const f32x4*)(u_s + fr * 16 + fq * 8), c2 = *(const f32x4*)(u_s + fr * 16 + fq * 8 + 4);
            uw[0] = pk_bf16(a[0], a[1]); uw[1] = pk_bf16(a[2], a[3]); uw[2] = pk_bf16(c2[0], c2[1]); uw[3] = pk_bf16(c2[2], c2[3]);
          }
          const bf16x8 ufrag = __builtin_bit_cast(bf16x8, uw);
#pragma unroll
          for (int nt = 0; nt < 8; ++nt) {
            const f32x4 d = __builtin_amdgcn_mfma_f32_16x16x32_bf16(bfrag[nt], ufrag, (f32x4){0.f, 0.f, 0.f, 0.f}, 0, 0, 0);
            *(f32x4*)(x_s + fr * 132 + 16 * nt + 4 * fq) = d;
          }
        }
        asm volatile("" ::: "memory");
        if (pass == 0) {
#pragma unroll
          for (int t = 0; t < 16; ++t) {
            const float xr = x_s[t * 132 + lane], xi = x_s[t * 132 + 64 + lane];
            const float nh = lr * hr - li * hi + xr, ni = lr * hi + li * hr + xi;
            hr = nh; hi = ni;
          }
          { const float npr = pr * l16r - pi * l16i, npi = pr * l16i + pi * l16r; pr = npr; pi = npi; }
        } else {
#pragma unroll
          for (int t = 0; t < 16; ++t) {
            const float xr = x_s[t * 132 + lane], xi = x_s[t * 132 + 64 + lane];
            const float nh = lr * hr - li * hi + xr, ni = lr * hi + li * hr + xi;
            hr = nh; hi = ni;
            const unsigned pk = pk_bf16(hr, hi);
            h_s[t * 136 + lane] = (bf16_t)(pk & 0xffff);
            h_s[t * 136 + 64 + lane] = (bf16_t)(pk >> 16);
          }
          asm volatile("" ::: "memory");
          f32x4 acc = (f32x4){0.f, 0.f, 0.f, 0.f};
#pragma unroll
          for (int kk = 0; kk < 4; ++kk) {
            const bf16x8 a = *(const bf16x8*)(h_s + fr * 136 + kk * 32 + fq * 8);
            acc = __builtin_amdgcn_mfma_f32_16x16x32_bf16(cfrag[kk], a, acc, 0, 0, 0);
          }
          {
            const f32x4 uv = *(const f32x4*)(u_s + fr * 16 + fq * 4);
            f32x4 y;
#pragma unroll
            for (int j = 0; j < 4; ++j) y[j] = gelu_tanh(acc[j] + dsk4[j] * uv[j]);
            *(u32x2*)(yb + ((size_t)(b * SEQL + t0 + sbk * 16 + fr)) * DM + g * 16 + fq * 4) = pk4(y);
          }
        }
        asm volatile("" ::: "memory");
      }
      if (pass == 0) {
        *(f32x4*)(xch + (wave * 64 + lane) * 4) = (f32x4){hr, hi, pr, pi};
        __syncthreads();
        hr = 0.f; hi = 0.f;
        for (int w2 = 0; w2 < wave; ++w2) {
          const f32x4 e = *(const f32x4*)(xch + (w2 * 64 + lane) * 4);
          const float nh = e[2] * hr - e[3] * hi + e[0], ni = e[2] * hi + e[3] * hr + e[1];
          hr = nh; hi = ni;
        }
      }
    }
    if (wave == 7) {
      p.out[O_PRE + ((size_t)(li_ * 4 + b) * 64 + g) * 64 + lane] = hr;
      p.out[O_PIM + ((size_t)(li_ * 4 + b) * 64 + g) * 64 + lane] = hi;
    }
    __syncthreads();
  }
  const bool same_g = ((gridDim.x * 8) & 63) == 0;
  SsmLane sp;
  if (same_g) ssm_lane_params(p, li_, (blockIdx.x * 8 + wave) & 63, lane, sp);
  for (int item = blockIdx.x * 8 + wave; item < 128 * 64; item += gridDim.x * 8) {
    const int sb = item >> 6, g = item & 63;
    if (!same_g) ssm_lane_params(p, li_, g, lane, sp);
    const bf16_t* up = uf + (size_t)(TP + sb) * DM + g * 16;
    float uu[16];
#pragma unroll
    for (int c4 = 0; c4 < 4; ++c4) { const u32x2 w_ = *(const u32x2*)(up + c4 * 4); f32x4 v; v[0] = bfw_lo(w_[0]); v[1] = bfw_hi(w_[0]); v[2] = bfw_lo(w_[1]); v[3] = bfw_hi(w_[1]); uu[c4 * 4] = v[0]; uu[c4 * 4 + 1] = v[1]; uu[c4 * 4 + 2] = v[2]; uu[c4 * 4 + 3] = v[3]; }
    float xr = 0.f, xi = 0.f;
#pragma unroll
    for (int c = 0; c < 16; ++c) { xr += sp.bbr[c] * uu[c]; xi += sp.bbi[c] * uu[c]; }
    const size_t sidx = ((size_t)(li_ * 128 + sb) * 64 + g) * 64 + lane;
    const float sr = p.in[5][sidx], si = p.in[6][sidx];
    const float hr = sp.lr * sr - sp.li * si + xr, hi = sp.lr * si + sp.li * sr + xi;
    p.out[O_SRE + sidx] = hr; p.out[O_SIM + sidx] = hi;
    float ymine = 0.f;
#pragma unroll
    for (int c = 0; c < 16; ++c) {
      float v = cre[((size_t)(g * 16 + c)) * 64 + lane] * hr - cim[((size_t)(g * 16 + c)) * 64 + lane] * hi;
#pragma unroll
      for (int o = 32; o >= 1; o >>= 1) v += __shfl_xor(v, o);
      ymine = (lane == c) ? v : ymine;
    }
    if (lane < 16) {
      float un = uu[0];
#pragma unroll
      for (int c = 1; c < 16; ++c) un = (lane == c) ? uu[c] : un;
      const float y = ymine + dsk[g * 16 + lane] * un;
      yb[(size_t)(TP + sb) * DM + g * 16 + lane] = (bf16_t)(pk_bf16(gelu_tanh(y), 0.f) & 0xffff);
    }
  }
}


#define XB_TMO      128
#define XB_XCNT(j)  (256  + 64 * (j))
#define XB_XSUB(j)  (1280 + 64 * (j))
#define XB_XGEN(j)  (2304 + 64 * (j))
#define XB_TOP      3328
#define XB_TOPGEN   3392
#define XCD_BAR_WORDS 3456
#define XB_SPIN_CAP (1u << 18)
__device__ __forceinline__ unsigned xb_ld(unsigned* p)              { return __hip_atomic_load(p, __ATOMIC_RELAXED, __HIP_MEMORY_SCOPE_AGENT); }
__device__ __forceinline__ unsigned xb_add(unsigned* p, unsigned v) { return __hip_atomic_fetch_add(p, v, __ATOMIC_RELAXED, __HIP_MEMORY_SCOPE_AGENT); }
__device__ __forceinline__ unsigned xb_xcc_id() { return (unsigned)__builtin_amdgcn_s_getreg((3 << 11) | 20) & 0xFu; }
#define XB_SPIN(cond, bar) do { unsigned _sp = 0; while (cond) { __builtin_amdgcn_s_sleep(1); \
    if ((++_sp & 255u) == 0u) { if (xb_ld(&(bar)[XB_TMO])) break; if (_sp > XB_SPIN_CAP) { atomicAdd(&(bar)[XB_TMO], 1u); break; } } } } while (0)
struct XcdBarrier { unsigned* bar; unsigned x; volatile LAS unsigned* st; };
__device__ __forceinline__ XcdBarrier xcd_barrier_post(unsigned* bar, volatile LAS unsigned* st) {
  XcdBarrier b; b.bar = bar; b.x = xb_xcc_id(); b.st = st;
  if (threadIdx.x == 0) (void)xb_add(&bar[XB_XCNT(b.x)], 1u);
  return b;
}
__device__ __forceinline__ void xcd_barrier_complete(unsigned* bar, unsigned x, unsigned& nloc, unsigned& nx) {
  const unsigned G = gridDim.x * gridDim.y * gridDim.z;
  unsigned sum, cnt, mine, sp = 0u;
  for (;;) {
    sum = 0u; cnt = 0u; mine = 0u;
#pragma unroll
    for (unsigned j = 0; j < 16; ++j) { const unsigned c = xb_ld(&bar[XB_XCNT(j)]); sum += c; cnt += (c > 0u) ? 1u : 0u; mine = (j == x) ? c : mine; }
    if (sum == G) break;
    __builtin_amdgcn_s_sleep(1);
    if ((++sp & 255u) == 0u) { if (xb_ld(&bar[XB_TMO])) break; if (sp > XB_SPIN_CAP) { atomicAdd(&bar[XB_TMO], 1u); break; } }
  }
  nloc = mine > 0u ? mine : 1u; nx = cnt > 0u ? cnt : 1u;
}
__device__ __forceinline__ void xcd_barrier(const XcdBarrier& b) {
  asm volatile("s_waitcnt vmcnt(0)" ::: "memory");
  __syncthreads();
  if (threadIdx.x == 0) {
    unsigned* bar = b.bar;
    __builtin_amdgcn_s_waitcnt(0);
    unsigned nloc = b.st[0], nx = b.st[1];
    if (nloc == 0u) { xcd_barrier_complete(bar, b.x, nloc, nx); b.st[0] = nloc; b.st[1] = nx; }
    const unsigned old = xb_add(&bar[XB_XSUB(b.x)], 1u);
    const unsigned gen = old / nloc;
    if (old + 1u == (gen + 1u) * nloc) {
      __builtin_amdgcn_fence(__ATOMIC_RELEASE, "agent");
      asm volatile("s_waitcnt vmcnt(0)" ::: "memory");
      const unsigned og = xb_add(&bar[XB_TOP], 1u);
      const unsigned tg = og / nx;
      if (og + 1u == (tg + 1u) * nx) xb_add(&bar[XB_TOPGEN], 1u);
      else XB_SPIN(xb_ld(&bar[XB_TOPGEN]) == tg, bar);
      __builtin_amdgcn_fence(__ATOMIC_ACQUIRE, "agent");
      xb_add(&bar[XB_XGEN(b.x)], 1u);
      asm volatile("s_waitcnt vmcnt(0)" ::: "memory");
    } else {
      XB_SPIN(xb_ld(&bar[XB_XGEN(b.x)]) == gen, bar);
      __builtin_amdgcn_fence(__ATOMIC_ACQUIRE, "agent");
      asm volatile("s_waitcnt vmcnt(0)" ::: "memory");
    }
  }
  __syncthreads();
}

template <int PH>
__device__ __forceinline__ void run_phase(LAS char* lds, char* shm_raw) {
  unsigned long long kp_ = (unsigned long long)__builtin_amdgcn_kernarg_segment_ptr();
  asm volatile("" : "+s"(kp_));
  const __attribute__((address_space(4))) unsigned long long* ka_ = (const __attribute__((address_space(4))) unsigned long long*)kp_;
  P p;
#pragma unroll
  for (int q = 0; q < 31; ++q) p.in[q] = (const float*)(const __attribute__((address_space(1))) float*)ka_[q];
  p.out = (float*)(__attribute__((address_space(1))) float*)ka_[31]; p.ws = (char*)(__attribute__((address_space(1))) char*)ka_[32];
  char* ws = p.ws;
  bf16_t* x = (bf16_t*)(ws + B_X); bf16_t* xb = (bf16_t*)(ws + B_XB); float* ssq = (float*)(ws + B_SSQ);
  bf16_t* hid = (bf16_t*)(ws + B_HID); bf16_t* cat = (bf16_t*)(ws + B_CAT);
  if constexpr (PH == 0) {
    phase_init(p, (float*)shm_raw);
  } else if constexpr (PH == NPHASE - 1) {
    phase_final(p);
  } else {
    constexpr int l = (PH - 1) / 7, k = (PH - 1) % 7, i = l >> 1;
    constexpr bool even = (l & 1) == 0;
    if constexpr (k == 0 || k == 5) {
      EpiSwiglu e; e.hid = hid; e.ssq = ssq;
      gemm_phase(xb, (const bf16_t*)(ws + W_GU + (size_t)(l * 2 + (k == 5)) * SZ_GU), 5632, 1024, e, lds, TPAD / G8_BM, ssq);
    } else if constexpr (k == 1 || k == 6) {
      EpiResid e; e.xl = x; e.xb = xb; e.ssq = ssq; e.alpha = 0.5f;
      const bf16_t* wd_ = (const bf16_t*)(ws + W_DOWN + (size_t)(l * 2 + (k == 6)) * SZ_DOWN);
      MiniResid me; me.xl = x; me.xb = xb; me.ssq = ssq; me.alpha = 0.5f;
      mini_phase(hid, wd_, 2816, me, shm_raw);
      gemm_phase(hid, wd_, 1024, 2816, e, lds, 64);
    } else if constexpr (k == 2) {
      if constexpr (even) {
        EpiAbIn e; e.qb = (bf16_t*)(ws + B_QB); e.kb = (bf16_t*)(ws + B_KB); e.vb = (bf16_t*)(ws + B_VB); e.zb = (bf16_t*)(ws + B_ZB);
        e.rope = (const float*)(ws + B_ROPE); e.out = p.out; e.li = i; e.ssq = ssq;
        gemm_phase(xb, (const bf16_t*)(ws + W_ABIN + (size_t)i * SZ_ABIN), 1792, 1024, e, lds, TPAD / G8_BM, ssq);
      } else {
        EpiSsmIn e; e.uf = (bf16_t*)(ws + B_UF); e.ssq = ssq;
        MiniSsmIn me; me.uf = (bf16_t*)(ws + B_UF); me.ssq = ssq;
        mini_phase(xb, (const bf16_t*)(ws + W_SSMIN + (size_t)i * SZ_SQ), 1024, me, shm_raw);
        gemm_phase(xb, (const bf16_t*)(ws + W_SSMIN + (size_t)i * SZ_SQ), 1024, 1024, e, lds, 64, ssq);
      }
    } else if constexpr (k == 3) {
      if constexpr (even) phase_mix_ab(p, i, shm_raw); else phase_ssm(p, i, shm_raw);
    } else {
      if constexpr (even) {
        EpiResid e; e.xl = x; e.xb = xb; e.ssq = ssq; e.alpha = 1.0f;
        MiniResid me; me.xl = x; me.xb = xb; me.ssq = ssq; me.alpha = 1.0f;
        mini_phase(cat, (const bf16_t*)(ws + W_ABOUT + (size_t)i * SZ_SQ), 1024, me, shm_raw);
        gemm_phase(cat, (const bf16_t*)(ws + W_ABOUT + (size_t)i * SZ_SQ), 1024, 1024, e, lds, 64);
      } else {
        EpiResidGlu e; e.xl = x; e.xb = xb; e.ssq = ssq;
        mini_glu_phase(cat, (const bf16_t*)(ws + W_GLU + (size_t)i * SZ_GLU), x, xb, ssq, shm_raw);
        gemm_phase(cat, (const bf16_t*)(ws + W_GLU + (size_t)i * SZ_GLU), 2048, 1024, e, lds, 64);
      }
    }
  }
}

template <int PH>
__device__ __forceinline__ void run_from(LAS char* lds, char* shm_raw, int lo, int hi, const XcdBarrier& xb) {
  if constexpr (PH < NPHASE) {
    if (PH >= lo && PH < hi) {
      run_phase<PH>(lds, shm_raw);
      constexpr int kk_ = (PH >= 1 && PH < NPHASE - 1) ? (PH - 1) % 7 : -1;
      constexpr bool odd_ = (PH >= 1 && PH < NPHASE - 1) ? ((((PH - 1) / 7) & 1) == 1) : false;
      constexpr bool rep_ = (PROBE_GU && (kk_ == 0 || kk_ == 5)) || (PROBE_INIT && PH == 0) || (PROBE_SSM && kk_ == 3 && odd_) || (PROBE_MIX && kk_ == 3 && !odd_ && PH > 0);
      if constexpr (rep_) { xcd_barrier(xb); run_phase<PH>(lds, shm_raw); }
      if (PH + 1 < hi) { if constexpr (PH == 0) cg::this_grid().sync(); else xcd_barrier(xb); }
    }
    run_from<PH + 1>(lds, shm_raw, lo, hi, xb);
  }
}

__global__ __launch_bounds__(512, 2) void mega(P p_arg, int lo, int hi) {
  __shared__ __attribute__((aligned(1024))) char shm_raw[131072 + 2048];
  LAS char* lds = (LAS char*)shm_raw;
  __shared__ uint4 xb_words;
  if (threadIdx.x == 0) xb_words = make_uint4(0u, 0u, 0u, 0u);
  __syncthreads();
  const XcdBarrier xb = xcd_barrier_post((unsigned*)(p_arg.ws + B_BAR), (volatile LAS unsigned*)&xb_words);
  run_from<0>(lds, shm_raw, lo, hi, xb);
}

extern "C" void kernel_launch(void* const* d_in, const int* in_sizes, int n_in, void* d_out, int out_size, void* d_ws,
                              size_t ws_size, hipStream_t stream) {
  static int grid_blocks = 0;
  if (!grid_blocks) {
    int dev = 0, cus = 0, per_cu = 0;
    hipGetDevice(&dev);
    hipDeviceGetAttribute(&cus, hipDeviceAttributeMultiprocessorCount, dev);
    hipOccupancyMaxActiveBlocksPerMultiprocessor(&per_cu, mega, 512, 0);
    if (per_cu < 1) per_cu = 1;
    grid_blocks = cus;
    if (ws_size < WS_NEED) fprintf(stderr, "workspace too small: %zu < %zu\n", ws_size, (size_t)WS_NEED);
  }
  P p{};
  for (int i = 0; i < 31; ++i) p.in[i] = (const float*)d_in[i];
  p.out = (float*)d_out;
  p.ws = (char*)d_ws;
#if MULTI_LAUNCH
  for (int ph = 0; ph < NPHASE; ++ph) {
    int lo = ph, hi = ph + 1;
    hipLaunchKernelGGL(mega, dim3(grid_blocks), dim3(512), 0, stream, p, lo, hi);
  }
#else
  hipMemsetAsync((char*)d_ws + B_BAR, 0, 16384, stream);
  int lo = 0, hi = NPHASE;
  void* args[] = {&p, &lo, &hi};
  hipError_t e = hipLaunchCooperativeKernel((void*)mega, dim3(grid_blocks), dim3(512), args, 0, stream);
  if (e != hipSuccess) fprintf(stderr, "cooperative launch failed: %s (grid %d)\n", hipGetErrorString(e), grid_blocks);
#endif
}
```
